# Optimizing an MI355X kernel written in HIP

```python
import math
import jax, jax.numpy as jnp
from jax import lax
import numpy as np

D_MODEL = 1024
BATCH = 8
SEQ = 2048
DEPTH = 4
DEC_BATCH = 128
DEC_SEQ = 8
PAST_LEN = 16384
PAGE_SIZE = 128

N_META = 16
CHUNK = 64
DN_HEADS = 4
DN_HEAD_DIM = 128
DN_WIDTH = DN_HEADS * DN_HEAD_DIM
CONV_W = 4
ML_HEADS = 4
ML_HEAD_DIM = 128
ML_WIDTH = ML_HEADS * ML_HEAD_DIM
S5_GROUP = 16
S5_WIDTH = 512
S5_GROUPS = S5_WIDTH // S5_GROUP
S5_STATE = 64
N_BRANCH = 3
EPS = 1e-6
NEG = -1e30

IN_SIZES = (3 * DN_WIDTH, DN_WIDTH, DN_HEADS, DN_HEADS,
            3 * ML_WIDTH, ML_WIDTH, ML_WIDTH, ML_HEADS, ML_HEADS,
            S5_WIDTH, S5_WIDTH, N_BRANCH * D_MODEL)
IN_COLS = 4 * DN_WIDTH + 2 * DN_HEADS + 5 * ML_WIDTH + 2 * ML_HEADS + 2 * S5_WIDTH + N_BRANCH * D_MODEL

kernel_name = 'hybrid_gdn_mlstm_s5_decode_step'


def f32(a):
    return a.astype(jnp.float32)


def rms_norm(x, w):
    x32 = x.astype(jnp.float32)
    y = x32 * lax.rsqrt(jnp.mean(x32 * x32, axis=-1, keepdims=True) + EPS)
    return (y * w.astype(jnp.float32)).astype(x.dtype)


def l2_normalize(x):
    return x * lax.rsqrt(jnp.sum(x * x, axis=-1, keepdims=True) + EPS)


def split_cols(a, sizes):
    cuts, acc = [], 0
    for s in sizes[:-1]:
        acc += s
        cuts.append(acc)
    return jnp.split(a, cuts, axis=-1)


def causal_conv(buf, u, w):
    t = u.shape[1]
    up = jnp.concatenate([buf, u], axis=1)
    out = w[0] * up[:, 0:t]
    for j in range(1, CONV_W):
        out = out + w[j] * up[:, j:j + t]
    return jax.nn.silu(out), up[:, t:]


def run_chunks(step, state, xs, is_prompt):
    if not is_prompt:
        return step(state, *xs)
    state, out_meta = step(state, *[a[:, :N_META] for a in xs])
    bsz, t = xs[0].shape[0], xs[0].shape[1]
    n = (t - N_META) // CHUNK

    def to_chunks(a):
        a = a[:, N_META:]
        return jnp.swapaxes(a.reshape((bsz, n, CHUNK) + a.shape[2:]), 0, 1)

    state, out = lax.scan(lambda s, c: step(s, *c), state, tuple(to_chunks(a) for a in xs))
    out = jnp.swapaxes(out, 0, 1).reshape((bsz, n * CHUNK) + out.shape[3:])
    return state, jnp.concatenate([out_meta, out], axis=1)


def gated_delta_chunk(s, q, k, v, g, beta):
    q, k, v = (jnp.swapaxes(a, 1, 2) for a in (q, k, v))
    g, beta = jnp.swapaxes(g, 1, 2), jnp.swapaxes(beta, 1, 2)
    L = q.shape[2]
    tril = jnp.tril(jnp.ones((L, L), dtype=bool))
    strict = jnp.tril(jnp.ones((L, L), dtype=bool), -1)
    G = jnp.cumsum(g, axis=-1)
    decay = jnp.where(tril, jnp.exp(jnp.where(tril, G[..., :, None] - G[..., None, :], 0.0)), 0.0)
    kb = k * beta[..., None]
    a = jnp.where(strict, jnp.einsum('bhik,bhjk->bhij', kb, k) * decay, 0.0)
    lhs = a + jnp.eye(L, dtype=a.dtype)
    rhs = jnp.concatenate([v * beta[..., None], kb * jnp.exp(G)[..., None]], axis=-1)
    sol = lax.linalg.triangular_solve(lhs, rhs, left_side=True, lower=True, unit_diagonal=True)
    dv = v.shape[-1]
    u, w = sol[..., :dv], sol[..., dv:]
    v_new = u - jnp.einsum('bhlk,bhkv->bhlv', w, s)
    attn = jnp.einsum('bhik,bhjk->bhij', q, k) * decay
    o = jnp.einsum('bhlk,bhkv->bhlv', q * jnp.exp(G)[..., None], s) + jnp.einsum('bhij,bhjv->bhiv', attn, v_new)
    g_last = G[..., -1:]
    s = s * jnp.exp(g_last)[..., None] + jnp.einsum('bhlk,bhlv->bhkv', k * jnp.exp(g_last - G)[..., None], v_new)
    return s, jnp.swapaxes(o, 1, 2)


def mlstm_chunk(state, q, k, v, ig, lf):
    c, n, m = state
    q, k, v = (jnp.swapaxes(a, 1, 2) for a in (q, k, v))
    ig, lf = jnp.swapaxes(ig, 1, 2), jnp.swapaxes(lf, 1, 2)
    L = q.shape[2]
    tril = jnp.tril(jnp.ones((L, L), dtype=bool))
    b = jnp.cumsum(lf, axis=-1)
    inter = b + m[..., None]
    logd = jnp.where(tril, b[..., :, None] - b[..., None, :] + ig[..., None, :], NEG)
    m_t = jnp.maximum(inter, jnp.max(logd, axis=-1))
    w_intra = jnp.exp(logd - m_t[..., None])
    w_inter = jnp.exp(inter - m_t)
    sc = jnp.einsum('bhik,bhjk->bhij', q, k) * w_intra
    num = w_inter[..., None] * jnp.einsum('bhlk,bhkv->bhlv', q, c) + jnp.einsum('bhij,bhjv->bhiv', sc, v)
    den = w_inter * jnp.einsum('bhlk,bhk->bhl', q, n) + jnp.sum(sc, axis=-1)
    h = num / jnp.maximum(jnp.abs(den), jnp.exp(-m_t))[..., None]
    m_new = m_t[..., -1]
    w_state = jnp.exp(b[..., -1:] - b + ig - m_new[..., None])
    carry = jnp.exp(b[..., -1] + m - m_new)
    c = carry[..., None, None] * c + jnp.einsum('bhl,bhlk,bhlv->bhkv', w_state, k, v)
    n = carry[..., None] * n + jnp.einsum('bhl,bhlk->bhk', w_state, k)
    return (c, n, m_new), jnp.swapaxes(h, 1, 2)


def ssm_combine(x, y):
    a1, b1 = x
    a2, b2 = y
    return a1 * a2, a2 * b1 + b2


def s5_mixer(h0_re, h0_im, u, lam_re, lam_im, log_dt, b_re, b_im, c_re, c_im, d):
    bsz, t = u.shape[0], u.shape[1]
    lam = lax.complex(lam_re, lam_im)
    lam_bar = jnp.exp(lam * jnp.exp(log_dt)[:, None])
    b_bar = ((lam_bar - 1.0) / lam)[..., None] * lax.complex(b_re, b_im)
    ug = u.reshape(bsz, t, S5_GROUPS, S5_GROUP).astype(jnp.complex64)
    bu = jnp.einsum('gph,btgh->btgp', b_bar, ug)
    bu = bu.at[:, 0].add(lam_bar * lax.complex(h0_re, h0_im))
    a = jnp.broadcast_to(lam_bar, bu.shape)
    _, hs = lax.associative_scan(ssm_combine, (a, bu), axis=1)
    y = jnp.einsum('ghp,btgp->btgh', lax.complex(c_re, c_im), hs).real.reshape(bsz, t, S5_WIDTH) + d * u
    return y, hs[:, -1].real, hs[:, -1].imag


def hybrid_layer(x, state, p, is_prompt):
    conv_buf, dn_s, ml_c, ml_n, ml_m, s5_re, s5_im = state
    (norm_w, w_in, b_gate, dn_conv_w, dn_a_log, dn_dt_bias, dn_norm_w,
     ml_bias_i, ml_bias_f, ml_norm_w, s5_lambda_re, s5_lambda_im, s5_log_dt,
     s5_b_re, s5_b_im, s5_c_re, s5_c_im, s5_d, s5_w_glu, s5_b_glu,
     w_branch_dn, w_branch_ml, w_branch_s5, w_out) = p
    dt = x.dtype
    bsz, t = x.shape[0], x.shape[1]
    h = rms_norm(x, norm_w)
    proj = jnp.einsum('btd,de->bte', h, w_in).astype(jnp.float32)
    (dn_qkv, dn_z, dn_a, dn_b, ml_qkv, ml_o, ml_z, ml_i, ml_f,
     s5_u, s5_z, gate_logits) = split_cols(proj, IN_SIZES)

    qkv, new_conv = causal_conv(conv_buf, dn_qkv, f32(dn_conv_w))
    q, k, v = [a.reshape(bsz, t, DN_HEADS, DN_HEAD_DIM) for a in jnp.split(qkv, 3, axis=-1)]
    q = l2_normalize(q) * (DN_HEAD_DIM ** -0.5)
    k = l2_normalize(k)
    g = -jnp.exp(f32(dn_a_log)) * jax.nn.softplus(dn_a + f32(dn_dt_bias))
    beta = jax.nn.sigmoid(dn_b)
    new_dn_s, o_dn = run_chunks(gated_delta_chunk, dn_s, (q, k, v, g, beta), is_prompt)
    o_dn = rms_norm(o_dn, dn_norm_w) * jax.nn.silu(dn_z.reshape(bsz, t, DN_HEADS, DN_HEAD_DIM))
    o_dn = o_dn.reshape(bsz, t, DN_WIDTH)

    q, k, v = [a.reshape(bsz, t, ML_HEADS, ML_HEAD_DIM) for a in jnp.split(ml_qkv, 3, axis=-1)]
    k = k * (ML_HEAD_DIM ** -0.5)
    ig = ml_i + f32(ml_bias_i)
    lf = jax.nn.log_sigmoid(ml_f + f32(ml_bias_f))
    (new_c, new_n, new_m), h_ml = run_chunks(mlstm_chunk, (ml_c, ml_n, ml_m), (q, k, v, ig, lf), is_prompt)
    o_ml = rms_norm(h_ml, ml_norm_w).reshape(bsz, t, ML_WIDTH) * jax.nn.sigmoid(ml_o) * jax.nn.silu(ml_z)

    y5, new_re, new_im = s5_mixer(s5_re, s5_im, s5_u, f32(s5_lambda_re), f32(s5_lambda_im), f32(s5_log_dt),
                                  f32(s5_b_re), f32(s5_b_im), f32(s5_c_re), f32(s5_c_im), f32(s5_d))
    y5 = jax.nn.gelu(y5)
    y5 = y5 * jax.nn.sigmoid(y5 @ f32(s5_w_glu) + f32(s5_b_glu))
    o_s5 = y5 * jax.nn.silu(s5_z)

    gates = jax.nn.sigmoid(gate_logits + f32(b_gate)).astype(dt).reshape(bsz, t, N_BRANCH, D_MODEL)
    mixed = (gates[:, :, 0] * (o_dn.astype(dt) @ w_branch_dn)
             + gates[:, :, 1] * (o_ml.astype(dt) @ w_branch_ml)
             + gates[:, :, 2] * (o_s5.astype(dt) @ w_branch_s5))
    x = x + mixed @ w_out
    return x, (new_conv, new_dn_s, new_c, new_n, new_m, new_re, new_im)


def run_trunk(x, states, params, is_prompt):
    per_layer = []
    for layer in range(DEPTH):
        st = tuple(s[layer].astype(jnp.float32) for s in states)
        x, new = hybrid_layer(x, st, tuple(w[layer] for w in params), is_prompt)
        per_layer.append(new)
    stacked = tuple(jnp.stack([new[i] for new in per_layer]).astype(x.dtype) for i in range(len(states)))
    return x, stacked


def setup_inputs(seed: int = 0) -> dict:
    key = jax.random.key(seed)
    ks = jax.random.split(key, 40)

    def nrm(i, shape, scale):
        return jax.random.normal(ks[i], shape, jnp.float32) * scale

    def gain(i, shape):
        return 1.0 + nrm(i, shape, 0.01)

    dn_dt = jnp.exp(jax.random.uniform(ks[15], (DEPTH, DN_HEADS), jnp.float32, math.log(1e-3), math.log(1e-1)))
    return {
        'x_prompt': nrm(0, (BATCH, SEQ, D_MODEL), 1.0),
        'x_sample': nrm(1, (DEC_BATCH, DEC_SEQ, D_MODEL), 1.0),
        'state_dn_conv': nrm(2, (DEPTH, DEC_BATCH, CONV_W - 1, 3 * DN_WIDTH), 1.0),
        'state_dn_s': nrm(3, (DEPTH, DEC_BATCH, DN_HEADS, DN_HEAD_DIM, DN_HEAD_DIM), 0.1),
        'state_ml_c': nrm(4, (DEPTH, DEC_BATCH, ML_HEADS, ML_HEAD_DIM, ML_HEAD_DIM), 0.1),
        'state_ml_n': nrm(5, (DEPTH, DEC_BATCH, ML_HEADS, ML_HEAD_DIM), 0.1),
        'state_ml_m': nrm(6, (DEPTH, DEC_BATCH, ML_HEADS), 1.0),
        'state_s5_re': nrm(7, (DEPTH, DEC_BATCH, S5_GROUPS, S5_STATE), 0.5),
        'state_s5_im': nrm(8, (DEPTH, DEC_BATCH, S5_GROUPS, S5_STATE), 0.5),
        'meta_tokens': nrm(9, (N_META, D_MODEL), 1.0),
        'norm_w': gain(10, (DEPTH, D_MODEL)),
        'w_in': nrm(11, (DEPTH, D_MODEL, IN_COLS), D_MODEL ** -0.5),
        'b_gate': nrm(12, (DEPTH, N_BRANCH * D_MODEL), 0.02),
        'dn_conv_w': nrm(13, (DEPTH, CONV_W, 3 * DN_WIDTH), CONV_W ** -0.5),
        'dn_a_log': jnp.log(jax.random.uniform(ks[14], (DEPTH, DN_HEADS), jnp.float32, 1.0, 16.0)),
        'dn_dt_bias': dn_dt + jnp.log(-jnp.expm1(-dn_dt)),
        'dn_norm_w': gain(16, (DEPTH, DN_HEAD_DIM)),
        'ml_bias_i': nrm(17, (DEPTH, ML_HEADS), 0.1),
        'ml_bias_f': jnp.linspace(3.0, 6.0, ML_HEADS, dtype=jnp.float32)[None, :] + nrm(18, (DEPTH, ML_HEADS), 0.1),
        'ml_norm_w': gain(19, (DEPTH, ML_HEAD_DIM)),
        's5_lambda_re': -0.5 + nrm(20, (DEPTH, S5_GROUPS, S5_STATE), 0.01),
        's5_lambda_im': math.pi * jnp.arange(S5_STATE, dtype=jnp.float32) + nrm(21, (DEPTH, S5_GROUPS, S5_STATE), 0.01),
        's5_log_dt': jax.random.uniform(ks[22], (DEPTH, S5_GROUPS), jnp.float32, math.log(1e-3), math.log(1e-1)),
        's5_b_re': nrm(23, (DEPTH, S5_GROUPS, S5_STATE, S5_GROUP), (2 * S5_GROUP) ** -0.5),
        's5_b_im': nrm(24, (DEPTH, S5_GROUPS, S5_STATE, S5_GROUP), (2 * S5_GROUP) ** -0.5),
        's5_c_re': nrm(25, (DEPTH, S5_GROUPS, S5_GROUP, S5_STATE), (2 * S5_STATE) ** -0.5),
        's5_c_im': nrm(26, (DEPTH, S5_GROUPS, S5_GROUP, S5_STATE), (2 * S5_STATE) ** -0.5),
        's5_d': nrm(27, (DEPTH, S5_WIDTH), 1.0),
        's5_w_glu': nrm(28, (DEPTH, S5_WIDTH, S5_WIDTH), S5_WIDTH ** -0.5),
        's5_b_glu': nrm(29, (DEPTH, S5_WIDTH), 0.02),
        'w_branch_dn': nrm(30, (DEPTH, DN_WIDTH, D_MODEL), DN_WIDTH ** -0.5),
        'w_branch_ml': nrm(31, (DEPTH, ML_WIDTH, D_MODEL), ML_WIDTH ** -0.5),
        'w_branch_s5': nrm(32, (DEPTH, S5_WIDTH, D_MODEL), S5_WIDTH ** -0.5),
        'w_out': nrm(33, (DEPTH, D_MODEL, D_MODEL), D_MODEL ** -0.5),
        'final_norm_w': gain(34, (D_MODEL,)),
    }


def reference(x_prompt, x_sample, state_dn_conv, state_dn_s, state_ml_c, state_ml_n, state_ml_m,
              state_s5_re, state_s5_im, meta_tokens, norm_w, w_in, b_gate, dn_conv_w, dn_a_log,
              dn_dt_bias, dn_norm_w, ml_bias_i, ml_bias_f, ml_norm_w, s5_lambda_re, s5_lambda_im,
              s5_log_dt, s5_b_re, s5_b_im, s5_c_re, s5_c_im, s5_d, s5_w_glu, s5_b_glu,
              w_branch_dn, w_branch_ml, w_branch_s5, w_out, final_norm_w):
    params = (norm_w, w_in, b_gate, dn_conv_w, dn_a_log, dn_dt_bias, dn_norm_w,
              ml_bias_i, ml_bias_f, ml_norm_w, s5_lambda_re, s5_lambda_im, s5_log_dt,
              s5_b_re, s5_b_im, s5_c_re, s5_c_im, s5_d, s5_w_glu, s5_b_glu,
              w_branch_dn, w_branch_ml, w_branch_s5, w_out)
    dt = x_prompt.dtype
    bsz = x_prompt.shape[0]

    xp = jnp.concatenate([jnp.broadcast_to(meta_tokens[None].astype(dt), (bsz, N_META, D_MODEL)), x_prompt], axis=1)

    def zeros(*shape):
        return jnp.zeros((DEPTH, bsz) + shape, jnp.float32)

    prompt_init = (zeros(CONV_W - 1, 3 * DN_WIDTH),
                   zeros(DN_HEADS, DN_HEAD_DIM, DN_HEAD_DIM),
                   zeros(ML_HEADS, ML_HEAD_DIM, ML_HEAD_DIM),
                   zeros(ML_HEADS, ML_HEAD_DIM),
                   jnp.full((DEPTH, bsz, ML_HEADS), NEG, jnp.float32),
                   zeros(S5_GROUPS, S5_STATE),
                   zeros(S5_GROUPS, S5_STATE))
    hp, (p_dn_conv, p_dn_s, p_ml_c, p_ml_n, p_ml_m, p_s5_re, p_s5_im) = run_trunk(xp, prompt_init, params, True)
    y_prompt = rms_norm(hp, final_norm_w)[:, N_META:]

    sample_init = (state_dn_conv, state_dn_s, state_ml_c, state_ml_n, state_ml_m, state_s5_re, state_s5_im)
    hs, (s_dn_conv, s_dn_s, s_ml_c, s_ml_n, s_ml_m, s_s5_re, s_s5_im) = run_trunk(x_sample, sample_init, params, False)
    y_sample = rms_norm(hs, final_norm_w)

    return (y_prompt, y_sample,
            p_dn_conv, p_dn_s, p_ml_c, p_ml_n, p_ml_m, p_s5_re, p_s5_im,
            s_dn_conv, s_dn_s, s_ml_c, s_ml_n, s_ml_m, s_s5_re, s_s5_im)
```

```cpp
#include <hip/hip_runtime.h>
#include <hip/hip_bf16.h>
#include <hip/hip_cooperative_groups.h>
#include <cstdio>
namespace cg = cooperative_groups;

typedef unsigned short u16;
using bf16x8 = __attribute__((ext_vector_type(8))) short;
using f32x4 = __attribute__((ext_vector_type(4))) float;


#define DIAG_SELF 0
#define S5_SYNTH 0
#ifndef REPEAT_MASK
#define REPEAT_MASK 0
#endif
#ifndef WS_PROBE_EXTRA
#define WS_PROBE_EXTRA 18100000
#endif
#ifndef MULTI_LAUNCH
#define MULTI_LAUNCH 0
#endif

constexpr int DEPTH_ = 4;
constexpr int MROWS = 17536;
constexpr int ROW_SAMPLE0 = 16384;
constexpr int ROW_META0 = 17408;
constexpr int MT = 137;
constexpr int PP = 5696;
constexpr int PN = 5648;
constexpr int NIN = 8720;
constexpr int NCHUNK = 392;
constexpr float NEGF = -1e30f;
constexpr float EPSF = 1e-6f;

constexpr int C_DNQ = 0, C_DNZ = 1536, C_DNA = 2048, C_DNB = 2052, C_MLQ = 2056, C_MLK = 2568, C_MLV = 3080,
              C_MLO = 3592, C_MLZ = 4104, C_MLI = 4616, C_MLF = 4620, C_S5U = 4624, C_S5Z = 5136, C_GATE = 5648;

constexpr size_t O_YP = 0;
constexpr size_t O_YS = O_YP + (size_t)8 * 2048 * 1024;
constexpr size_t O_PCONV = O_YS + (size_t)128 * 8 * 1024;
constexpr size_t O_PDNS = O_PCONV + (size_t)4 * 8 * 3 * 1536;
constexpr size_t O_PMLC = O_PDNS + (size_t)4 * 8 * 4 * 16384;
constexpr size_t O_PMLN = O_PMLC + (size_t)4 * 8 * 4 * 16384;
constexpr size_t O_PMLM = O_PMLN + (size_t)4 * 8 * 4 * 128;
constexpr size_t O_PS5R = O_PMLM + (size_t)4 * 8 * 4;
constexpr size_t O_PS5I = O_PS5R + (size_t)4 * 8 * 32 * 64;
constexpr size_t O_SCONV = O_PS5I + (size_t)4 * 8 * 32 * 64;
constexpr size_t O_SDNS = O_SCONV + (size_t)4 * 128 * 3 * 1536;
constexpr size_t O_SMLC = O_SDNS + (size_t)4 * 128 * 4 * 16384;
constexpr size_t O_SMLN = O_SMLC + (size_t)4 * 128 * 4 * 16384;
constexpr size_t O_SMLM = O_SMLN + (size_t)4 * 128 * 4 * 128;
constexpr size_t O_SS5R = O_SMLM + (size_t)4 * 128 * 4;
constexpr size_t O_SS5I = O_SS5R + (size_t)4 * 128 * 32 * 64;

constexpr size_t WS_WIN = 0;
constexpr size_t WS_WDN = WS_WIN + (size_t)4 * NIN * 1024 * 2;
constexpr size_t WS_WML = WS_WDN + (size_t)4 * 1024 * 512 * 2;
constexpr size_t WS_WS5 = WS_WML + (size_t)4 * 1024 * 512 * 2;
constexpr size_t WS_WOUT = WS_WS5 + (size_t)4 * 1024 * 512 * 2;
constexpr size_t WS_WGLU = WS_WOUT + (size_t)4 * 1024 * 1024 * 2;
constexpr size_t WS_XMETA = WS_WGLU + (size_t)4 * 512 * 512 * 2;
constexpr size_t WS_PROJ = WS_XMETA + (size_t)128 * 1024 * 4;
constexpr size_t WS_OBR = WS_PROJ + (size_t)MROWS * PP * 2;
constexpr size_t WS_Y5G = WS_OBR + (size_t)MROWS * 1536 * 2;
constexpr size_t DN_ITEM = 74240;
constexpr size_t ML_ITEM = 41984;
constexpr size_t WS_PDN = WS_Y5G + (size_t)MROWS * 512 * 2;
constexpr size_t WS_PML = WS_PDN + (size_t)NCHUNK * 4 * DN_ITEM;
constexpr size_t WS_END = WS_PML + (size_t)NCHUNK * 4 * ML_ITEM;
static_assert((size_t)MROWS * 3072 * 2 <= (size_t)NCHUNK * 4 * DN_ITEM, "gates alias");
static_assert((size_t)MROWS * 1024 * 2 <= (size_t)NCHUNK * 4 * ML_ITEM, "mixed alias");

constexpr int SMEM_BYTES = 136 * 1024;

struct Params {
  const float* in[37];
  float* out;
  unsigned char* ws;
  size_t y5g_off;
};

typedef __attribute__((ext_vector_type(2))) __bf16 bf2v;
__device__ __forceinline__ u16 f2bf(float f) {
  __bf16 h = (__bf16)f;
  return __builtin_bit_cast(u16, h);
}
__device__ __forceinline__ float bf2f(unsigned h) { return __uint_as_float((h & 0xffffu) << 16); }
__device__ __forceinline__ unsigned pack2(float a, float b) {
  bf2v r;
  r[0] = (__bf16)a; r[1] = (__bf16)b;
  return __builtin_bit_cast(unsigned, r);
}
__device__ __forceinline__ float sigmoidf_(float x) { return 1.f / (1.f + __expf(-x)); }
__device__ __forceinline__ float siluf_(float x) { return x / (1.f + __expf(-x)); }
__device__ __forceinline__ f32x4 mfma16(bf16x8 a, bf16x8 b, f32x4 c) {
  return __builtin_amdgcn_mfma_f32_16x16x32_bf16(a, b, c, 0, 0, 0);
}
__device__ __forceinline__ int opaque(int v) { asm volatile("" : "+v"(v)); return v; }
__device__ __forceinline__ bf16x8 ldg8(const u16* p) { return *reinterpret_cast<const bf16x8*>(p); }
__device__ __forceinline__ bf16x8 zero8() { bf16x8 z = {0, 0, 0, 0, 0, 0, 0, 0}; return z; }
__device__ __forceinline__ f32x4 zero4() { f32x4 z = {0.f, 0.f, 0.f, 0.f}; return z; }

__device__ __forceinline__ const float* pin(const Params& p, int i) {
  asm volatile("" : "+s"(i));
  return p.in[i];
}
__device__ __forceinline__ unsigned char* pws(const Params& p) { return (unsigned char*)pin(p, 36); }
__device__ __forceinline__ unsigned char* wsat(const Params& p, size_t off) {
  unsigned o = (unsigned)off;
  asm volatile("" : "+s"(o));
  return (unsigned char*)pin(p, 36) + o;
}
__device__ __forceinline__ float* pout(const Params& p) {
  return (float*)pin(p, 35);
}
__device__ __forceinline__ void touch_lines(const unsigned char* base, int nlines, int tid) {
  for (int i = tid; i < nlines; i += 256) {
    unsigned v = *(const unsigned*)(base + (size_t)i * 128);
    asm volatile("" :: "v"(v));
  }
}
__device__ __forceinline__ int opaque_s(int v) { asm volatile("" : "+s"(v)); return v; }
__device__ __forceinline__ float* xrow(const Params& p, int r) {
  return r < ROW_META0 ? pout(p) + (size_t)r * 1024 : (float*)(wsat(p, WS_XMETA)) + (size_t)(r - ROW_META0) * 1024;
}
__device__ __forceinline__ float* st_out(const Params& p, size_t offP, size_t offS, int layer, int q, size_t per) {
  return q < 8 ? pout(p) + offP + (size_t)(layer * 8 + q) * per : pout(p) + offS + (size_t)(layer * 128 + (q - 8)) * per;
}

struct ChunkInfo { int row0, Lv, q, hist, hrow, last; };
__device__ __forceinline__ ChunkInfo chunk_info(int ci) {
  ChunkInfo c;
  if (ci < 264) {
    int s = ci / 33, cc = ci % 33;
    c.q = s;
    c.last = (cc == 32);
    if (cc == 0) { c.row0 = ROW_META0 + s * 16; c.Lv = 16; c.hist = 0; c.hrow = 0; }
    else {
      c.row0 = s * 2048 + (cc - 1) * 64; c.Lv = 64; c.hist = 1;
      c.hrow = (cc == 1) ? (ROW_META0 + s * 16 + 13) : (c.row0 - 3);
    }
  } else {
    int s = ci - 264;
    c.q = 8 + s; c.row0 = ROW_SAMPLE0 + s * 8; c.Lv = 8; c.hist = 2; c.hrow = 0; c.last = 1;
  }
  return c;
}

__device__ __forceinline__ void transpose_tile(const float* __restrict__ src, int K, int N, u16* __restrict__ dst,
                               const float* __restrict__ scale, int kt, int nt, float* sT) {
  const int tid = opaque(threadIdx.x);
  __syncthreads();
  for (int e = tid; e < 4096; e += 256) {
    int kk = e >> 6, nn = e & 63;
    int n = nt * 64 + nn, k = kt * 64 + kk;
    float v = 0.f;
    if (n < N) { v = src[(size_t)k * N + n]; if (scale) v *= scale[k]; }
    sT[kk * 65 + nn] = v;
  }
  __syncthreads();
  for (int e = tid; e < 4096; e += 256) {
    int nn = e >> 6, kk = e & 63;
    int n = nt * 64 + nn;
    if (n < N) ((u16*)dst)[(size_t)n * K + kt * 64 + kk] = f2bf(sT[kk * 65 + nn]);
  }
}

__device__ __forceinline__ void phase0(const Params& p, unsigned char* smem, int bid, int G) {
  float* sT = (float*)smem;
  const int nIn = 4 * 16 * 137, nBr = 4 * 8 * 16, nOut = 4 * 16 * 16, nGlu = 4 * 8 * 8;
  const int total = nIn + 3 * nBr + nOut + nGlu;
  for (int it = bid; it < total; it += G) {
    int i = it;
    if (i < nIn) {
      int l = i / (16 * 137), r = i % (16 * 137);
      transpose_tile(pin(p, 11) + (size_t)l * 1024 * NIN, 1024, NIN, (u16*)(wsat(p, WS_WIN)) + (size_t)l * NIN * 1024,
                     pin(p, 10) + l * 1024, r / 137, r % 137, sT);
      continue;
    }
    i -= nIn;
    if (i < 3 * nBr) {
      int b = i / nBr, j = i % nBr;
      int l = j / 128, r = j % 128;
      const float* src = pin(p, 30 + b) + (size_t)l * 512 * 1024;
      u16* dst = (u16*)(pws(p) + (b == 0 ? WS_WDN : b == 1 ? WS_WML : WS_WS5)) + (size_t)l * 1024 * 512;
      transpose_tile(src, 512, 1024, dst, nullptr, r / 16, r % 16, sT);
      continue;
    }
    i -= 3 * nBr;
    if (i < nOut) {
      int l = i / 256, r = i % 256;
      transpose_tile(pin(p, 33) + (size_t)l * 1024 * 1024, 1024, 1024, (u16*)(wsat(p, WS_WOUT)) + (size_t)l * 1024 * 1024,
                     nullptr, r / 16, r % 16, sT);
      continue;
    }
    i -= nOut;
    {
      int l = i / 64, r = i % 64;
      transpose_tile(pin(p, 28) + (size_t)l * 512 * 512, 512, 512, (u16*)(wsat(p, WS_WGLU)) + (size_t)l * 512 * 512,
                     nullptr, r / 8, r % 8, sT);
    }
  }
  const size_t n4 = (size_t)MROWS * 256;
  for (size_t e = (size_t)bid * 256 + threadIdx.x; e < n4; e += (size_t)G * 256) {
    int r = (int)(e >> 8), c4 = (int)(e & 255);
    float4 v;
    if (r < ROW_SAMPLE0) v = ((const float4*)pin(p, 0))[(size_t)r * 256 + c4];
    else if (r < ROW_META0) v = ((const float4*)pin(p, 1))[(size_t)(r - ROW_SAMPLE0) * 256 + c4];
    else v = ((const float4*)pin(p, 9))[(size_t)((r - ROW_META0) & 15) * 256 + c4];
    ((float4*)xrow(p, r))[c4] = v;
  }
}

template <bool AF32, int TN>
__device__ __forceinline__ void gemm_kloop(f32x4 (&acc)[4][TN], const void* __restrict__ aptr,
                                           const u16* __restrict__ bptr, int K, u16* sA, u16* sB, float* ssq) {
  const int tid = opaque(threadIdx.x), lane = tid & 63, wave = tid >> 6;
  const int wm = wave >> 1, wn = wave & 1, fr = lane & 15, fq = lane >> 4;
  const int soff = (tid >> 1) * 136 + (tid & 1) * 64;
  constexpr int STG = 128 * 136;
  float sq = 0.f;
  const int nk = K / 128;
  float4 f0_0, f1_0, f2_0, f3_0, f4_0, f5_0, f6_0, f7_0, f8_0, f9_0, f10_0, f11_0, f12_0, f13_0, f14_0, f15_0, f0_1, f1_1, f2_1, f3_1, f4_1, f5_1, f6_1, f7_1, f8_1, f9_1, f10_1, f11_1, f12_1, f13_1, f14_1, f15_1;
  uint4 a0_0, a1_0, a2_0, a3_0, a4_0, a5_0, a6_0, a7_0, b0_0, b1_0, b2_0, b3_0, b4_0, b5_0, b6_0, b7_0, a0_1, a1_1, a2_1, a3_1, a4_1, a5_1, a6_1, a7_1, b0_1, b1_1, b2_1, b3_1, b4_1, b5_1, b6_1, b7_1;
#define SQ4(v) (v.x * v.x + v.y * v.y + v.z * v.z + v.w * v.w)
#define PK8(d, a, b) d.x = pack2(a.x, a.y); d.y = pack2(a.z, a.w); d.z = pack2(b.x, b.y); d.w = pack2(b.z, b.w)
#define GLOAD(S, kt) do { \
    if (AF32) { const float4* pa = (const float4*)((const float*)aptr + (kt) * 128); f0_##S = pa[0]; f1_##S = pa[1]; f2_##S = pa[2]; f3_##S = pa[3]; f4_##S = pa[4]; f5_##S = pa[5]; f6_##S = pa[6]; f7_##S = pa[7]; f8_##S = pa[8]; f9_##S = pa[9]; f10_##S = pa[10]; f11_##S = pa[11]; f12_##S = pa[12]; f13_##S = pa[13]; f14_##S = pa[14]; f15_##S = pa[15]; } \
    else { const uint4* pa = (const uint4*)((const u16*)aptr + (kt) * 128); a0_##S = pa[0]; a1_##S = pa[1]; a2_##S = pa[2]; a3_##S = pa[3]; a4_##S = pa[4]; a5_##S = pa[5]; a6_##S = pa[6]; a7_##S = pa[7]; } \
    if (TN == 4 || tid < 64 * TN) { const uint4* pb = (const uint4*)(bptr + (kt) * 128); b0_##S = pb[0]; b1_##S = pb[1]; b2_##S = pb[2]; b3_##S = pb[3]; b4_##S = pb[4]; b5_##S = pb[5]; b6_##S = pb[6]; b7_##S = pb[7]; } \
  } while (0)
#define SSTORE(S, buf) do { \
    if (AF32) { sq += SQ4(f0_##S) + SQ4(f1_##S) + SQ4(f2_##S) + SQ4(f3_##S) + SQ4(f4_##S) + SQ4(f5_##S) + SQ4(f6_##S) + SQ4(f7_##S) + SQ4(f8_##S) + SQ4(f9_##S) + SQ4(f10_##S) + SQ4(f11_##S) + SQ4(f12_##S) + SQ4(f13_##S) + SQ4(f14_##S) + SQ4(f15_##S); PK8(a0_##S, f0_##S, f1_##S); PK8(a1_##S, f2_##S, f3_##S); PK8(a2_##S, f4_##S, f5_##S); PK8(a3_##S, f6_##S, f7_##S); PK8(a4_##S, f8_##S, f9_##S); PK8(a5_##S, f10_##S, f11_##S); PK8(a6_##S, f12_##S, f13_##S); PK8(a7_##S, f14_##S, f15_##S); } \
    uint4* da = (uint4*)(sA + (buf) * STG + soff); da[0] = a0_##S; da[1] = a1_##S; da[2] = a2_##S; da[3] = a3_##S; da[4] = a4_##S; da[5] = a5_##S; da[6] = a6_##S; da[7] = a7_##S; \
    if (TN == 4 || tid < 64 * TN) { uint4* db = (uint4*)(sB + (buf) * STG + soff); db[0] = b0_##S; db[1] = b1_##S; db[2] = b2_##S; db[3] = b3_##S; db[4] = b4_##S; db[5] = b5_##S; db[6] = b6_##S; db[7] = b7_##S; } \
  } while (0)
  auto compute = [&](int buf) {
#pragma unroll
    for (int kk = 0; kk < 4; ++kk) {
      bf16x8 af[4], bfr[TN];
#pragma unroll
      for (int i = 0; i < 4; ++i) af[i] = *(const bf16x8*)(sA + buf * STG + (wm * 64 + i * 16 + fr) * 136 + kk * 32 + fq * 8);
#pragma unroll
      for (int j = 0; j < TN; ++j) bfr[j] = *(const bf16x8*)(sB + buf * STG + (wn * TN * 16 + j * 16 + fr) * 136 + kk * 32 + fq * 8);
#pragma unroll
      for (int i = 0; i < 4; ++i)
#pragma unroll
        for (int j = 0; j < TN; ++j) acc[i][j] = mfma16(af[i], bfr[j], acc[i][j]);
    }
  };
  __syncthreads();
  GLOAD(0, 0);
  GLOAD(1, 1);
  SSTORE(0, 0);
  __syncthreads();
  for (int kt = 0; kt < nk; kt += 2) {
    if (kt + 2 < nk) GLOAD(0, kt + 2);
    compute(0);
    SSTORE(1, 1);
    __syncthreads();
    if (kt + 3 < nk) GLOAD(1, kt + 3);
    compute(1);
    if (kt + 2 < nk) SSTORE(0, 0);
    __syncthreads();
  }
  if (AF32) *ssq = sq;
}

__device__ __forceinline__ u16* xnrow_fwd(const Params& p, int r) {
  return r < 8704 ? (u16*)wsat(p, WS_Y5G) + (size_t)r * 1024
                  : (u16*)wsat(p, WS_END + 8192) + (size_t)(r - 8704) * 1024;
}
struct GemmSmem {
  u16 A[2 * 128 * 136];
  u16 B[2 * 128 * 136];
};

template <int MODE>
__device__ __forceinline__ void gemm_in_tile(const Params& p, int layer_, int mt, int nt, unsigned char* smem) {
  const int layer = opaque_s(layer_);
  GemmSmem* s = (GemmSmem*)smem;
  const int tid = opaque(threadIdx.x), lane = tid & 63, wave = tid >> 6;
  const int wm = wave >> 1, wn = wave & 1, fr = lane & 15, fq = lane >> 4;
  const int m0 = mt * 128, n0 = nt * 128;
  const int N = MODE == 0 ? PN : 3072;
  const int wrow0 = MODE == 0 ? 0 : C_GATE;
  const u16* aptr = xnrow_fwd(p, m0 + (tid >> 1)) + (tid & 1) * 64;
  int bn = n0 + (tid >> 1); if (bn > N - 1) bn = N - 1;
  const u16* bptr = (const u16*)(wsat(p, WS_WIN)) + ((size_t)layer * NIN + wrow0 + bn) * 1024 + (tid & 1) * 64;
  f32x4 acc[4][4];
#pragma unroll
  for (int i = 0; i < 4; ++i)
#pragma unroll
    for (int j = 0; j < 4; ++j) acc[i][j] = zero4();
  gemm_kloop<false, 4>(acc, aptr, bptr, 1024, s->A, s->B, nullptr);
  u16* dst = MODE == 0 ? (u16*)(wsat(p, WS_PROJ)) : (u16*)(wsat(p, WS_PDN));
  const int pitch = MODE == 0 ? PP : 3072;
#pragma unroll
  for (int i = 0; i < 4; ++i)
#pragma unroll
    for (int r = 0; r < 4; ++r) {
      const int rl = wm * 64 + i * 16 + fq * 4 + r;
#pragma unroll
      for (int j = 0; j < 4; ++j) {
        const int col = n0 + wn * 64 + j * 16 + fr;
        if (col < N) {
          float v = acc[i][j][r];
          if (MODE == 1) v = sigmoidf_(v + pin(p, 12)[layer * 3072 + col]);
          dst[(size_t)(m0 + rl) * pitch + col] = f2bf(v);
        }
      }
    }
}

__device__ __forceinline__ void gemm_glu_tile(const Params& p, int layer_, int mt, int nt, unsigned char* smem) {
  const int layer = opaque_s(layer_);
  GemmSmem* s = (GemmSmem*)smem;
  const int tid = opaque(threadIdx.x), lane = tid & 63, wave = tid >> 6;
  const int wm = wave >> 1, wn = wave & 1, fr = lane & 15, fq = lane >> 4;
  const int m0 = mt * 128, n0 = nt * 128;
  const u16* y5g = (const u16*)(wsat(p, WS_Y5G));
  const u16* proj = (const u16*)(wsat(p, WS_PROJ));
  const u16* aptr = y5g + (size_t)(m0 + (tid >> 1)) * 512 + (tid & 1) * 64;
  const u16* bptr = (const u16*)(wsat(p, WS_WGLU)) + ((size_t)layer * 512 + n0 + (tid >> 1)) * 512 + (tid & 1) * 64;
  f32x4 acc[4][4];
#pragma unroll
  for (int i = 0; i < 4; ++i)
#pragma unroll
    for (int j = 0; j < 4; ++j) acc[i][j] = zero4();
  gemm_kloop<false, 4>(acc, aptr, bptr, 512, s->A, s->B, nullptr);
  u16* obr = (u16*)(wsat(p, WS_OBR));
#pragma unroll
  for (int i = 0; i < 4; ++i)
#pragma unroll
    for (int r = 0; r < 4; ++r) {
      const int row = m0 + wm * 64 + i * 16 + fq * 4 + r;
#pragma unroll
      for (int j = 0; j < 4; ++j) {
        const int col = n0 + wn * 64 + j * 16 + fr;
        float y = bf2f(y5g[(size_t)row * 512 + col]);
        float z = bf2f(proj[(size_t)row * PP + C_S5Z + col]);
        float v = y * sigmoidf_(acc[i][j][r] + pin(p, 29)[layer * 512 + col]) * siluf_(z);
        obr[(size_t)row * 1536 + 1024 + col] = f2bf(v);
      }
    }
}

__device__ __forceinline__ void gemm_mix_tile(const Params& p, int layer_, int mt, int nt, unsigned char* smem) {
  const int layer = opaque_s(layer_);
  GemmSmem* s = (GemmSmem*)smem;
  const int tid = opaque(threadIdx.x), lane = tid & 63, wave = tid >> 6;
  const int wm = wave >> 1, wn = wave & 1, fr = lane & 15, fq = lane >> 4;
  const int m0 = mt * 128, n0 = nt * 64;
  const u16* obr = (const u16*)(wsat(p, WS_OBR));
  const u16* gates = (const u16*)(wsat(p, WS_PDN));
  f32x4 res[4][2];
#pragma unroll
  for (int i = 0; i < 4; ++i)
#pragma unroll
    for (int j = 0; j < 2; ++j) res[i][j] = zero4();
#pragma unroll 1
  for (int b = 0; b < 3; ++b) {
    const u16* aptr = obr + (size_t)(m0 + (tid >> 1)) * 1536 + b * 512 + (tid & 1) * 64;
    const u16* wb = (const u16*)(pws(p) + (b == 0 ? WS_WDN : b == 1 ? WS_WML : WS_WS5));
    const u16* bptr = wb + ((size_t)layer * 1024 + n0 + ((tid >> 1) & 63)) * 512 + (tid & 1) * 64;
    f32x4 acc[4][2];
#pragma unroll
    for (int i = 0; i < 4; ++i)
#pragma unroll
      for (int j = 0; j < 2; ++j) acc[i][j] = zero4();
    gemm_kloop<false, 2>(acc, aptr, bptr, 512, s->A, s->B, nullptr);
#pragma unroll
    for (int i = 0; i < 4; ++i)
#pragma unroll
      for (int r = 0; r < 4; ++r) {
        const int row = m0 + wm * 64 + i * 16 + fq * 4 + r;
#pragma unroll
        for (int j = 0; j < 2; ++j) {
          const int col = n0 + wn * 32 + j * 16 + fr;
          float g = bf2f(gates[(size_t)row * 3072 + b * 1024 + col]);
          res[i][j][r] += g * acc[i][j][r];
        }
      }
  }
  u16* mixed = (u16*)(wsat(p, WS_PML));
#pragma unroll
  for (int i = 0; i < 4; ++i)
#pragma unroll
    for (int r = 0; r < 4; ++r) {
      const int row = m0 + wm * 64 + i * 16 + fq * 4 + r;
#pragma unroll
      for (int j = 0; j < 2; ++j) {
        const int col = n0 + wn * 32 + j * 16 + fr;
        mixed[(size_t)row * 1024 + col] = f2bf(res[i][j][r]);
      }
    }
}

__device__ __forceinline__ void gemm_out_tile(const Params& p, int layer_, int mt, int nt, unsigned char* smem) {
  const int layer = opaque_s(layer_);
  GemmSmem* s = (GemmSmem*)smem;
  const int tid = opaque(threadIdx.x), lane = tid & 63, wave = tid >> 6;
  const int wm = wave >> 1, wn = wave & 1, fr = lane & 15, fq = lane >> 4;
  const int m0 = mt * 128, n0 = nt * 128;
  const u16* mixed = (const u16*)(wsat(p, WS_PML));
  const u16* aptr = mixed + (size_t)(m0 + (tid >> 1)) * 1024 + (tid & 1) * 64;
  const u16* bptr = (const u16*)(wsat(p, WS_WOUT)) + ((size_t)layer * 1024 + n0 + (tid >> 1)) * 1024 + (tid & 1) * 64;
  f32x4 acc[4][4];
#pragma unroll
  for (int i = 0; i < 4; ++i)
#pragma unroll
    for (int j = 0; j < 4; ++j) acc[i][j] = zero4();
  gemm_kloop<false, 4>(acc, aptr, bptr, 1024, s->A, s->B, nullptr);
#pragma unroll
  for (int i = 0; i < 4; ++i)
#pragma unroll
    for (int r = 0; r < 4; ++r) {
      const int row = m0 + wm * 64 + i * 16 + fq * 4 + r;
      float* xr = xrow(p, row);
#pragma unroll
      for (int j = 0; j < 4; ++j) {
        const int col = n0 + wn * 64 + j * 16 + fr;
        xr[col] += acc[i][j][r];
      }
    }
}

__device__ __forceinline__ void prep_dn(const Params& p, int layer_, int ci, int h, unsigned char* smem) {
  const int layer = opaque_s(layer_);
  const int tid = opaque(threadIdx.x), lane = tid & 63, wave = tid >> 6, fr = lane & 15, fq = lane >> 4;
  const ChunkInfo c = chunk_info(ci);
  float* sAm = (float*)smem;
  float* sG = (float*)(smem + 17408);
  u16* qb = (u16*)(smem + 18432);
  u16* kb = qb + 64 * 136;
  u16* vb = kb + 64 * 136;
  float* sBeta = sG + 64;
  float* sEG = sBeta + 64;
  const u16* proj = (const u16*)(wsat(p, WS_PROJ));
  unsigned char* item = wsat(p, WS_PDN) + (size_t)(ci * 4 + h) * DN_ITEM;
  u16* gU = (u16*)item;
  u16* gW = gU + opaque_s(8192);
  u16* gQe = gW + opaque_s(8192);
  u16* gKdT = gQe + opaque_s(8192);
  u16* gAttn = gKdT + opaque_s(8192);
  float* gScal = (float*)(item + opaque_s(73728));

  __syncthreads();
  if (wave == 0) {
    float g = 0.f, beta = 0.f;
    if (lane < c.Lv) {
      const u16* pr = proj + (size_t)(c.row0 + lane) * PP;
      float a = bf2f(pr[C_DNA + h]), bb = bf2f(pr[C_DNB + h]);
      float x = a + pin(p, 15)[layer * 4 + h];
      float sp = x > 20.f ? x : log1pf(__expf(x));
      g = -__expf(pin(p, 14)[layer * 4 + h]) * sp;
      beta = sigmoidf_(bb);
    }
    float G = g;
#pragma unroll
    for (int d = 1; d < 64; d <<= 1) { float t = __shfl_up(G, d); if (lane >= d) G += t; }
    sG[lane] = G; sBeta[lane] = beta; sEG[lane] = __expf(G);
  }
  const float* convw = pin(p, 13) + (size_t)layer * 4 * 1536;
#pragma unroll 1
  for (int part = 0; part < 3; ++part) {
    const int cb = part * 512 + h * 128 + 2 * lane;
    float w0[4], w1[4];
#pragma unroll
    for (int j = 0; j < 4; ++j) { w0[j] = convw[j * 1536 + cb]; w1[j] = convw[j * 1536 + cb + 1]; }
    u16* dst = part == 0 ? qb : (part == 1 ? kb : vb);
#pragma unroll 8
    for (int rr = 0; rr < 16; ++rr) {
      const int l = wave * 16 + rr;
      float o0 = 0.f, o1 = 0.f;
      if (l < c.Lv) {
#pragma unroll
        for (int j = 0; j < 4; ++j) {
          const int i = l + j - 3;
          float x0 = 0.f, x1 = 0.f;
          if (i >= 0) {
            unsigned v = *(const unsigned*)(proj + (size_t)(c.row0 + i) * PP + cb);
            x0 = bf2f(v); x1 = bf2f(v >> 16);
          } else if (c.hist == 1) {
            unsigned v = *(const unsigned*)(proj + (size_t)(c.hrow + i + 3) * PP + cb);
            x0 = bf2f(v); x1 = bf2f(v >> 16);
          } else if (c.hist == 2) {
            const float* st = pin(p, 2) + ((size_t)(layer * 128 + (c.q - 8)) * 3 + (i + 3)) * 1536 + cb;
            x0 = st[0]; x1 = st[1];
          }
          o0 += w0[j] * x0; o1 += w1[j] * x1;
        }
        o0 = siluf_(o0); o1 = siluf_(o1);
      }
      if (part < 2) {
        float ss = o0 * o0 + o1 * o1;
#pragma unroll
        for (int d = 32; d >= 1; d >>= 1) ss += __shfl_xor(ss, d);
        float sc = rsqrtf(ss + EPSF);
        if (part == 0) sc *= 0.08838834764831845f;
        o0 *= sc; o1 *= sc;
      }
      *(unsigned*)(dst + l * 136 + 2 * lane) = pack2(o0, o1);
    }
  }
  __syncthreads();
  {
    f32x4 akk[4], aqk[4];
#pragma unroll
    for (int j = 0; j < 4; ++j) { akk[j] = zero4(); aqk[j] = zero4(); }
#pragma unroll
    for (int ks = 0; ks < 4; ++ks) {
      bf16x8 aq = *(const bf16x8*)(qb + (wave * 16 + fr) * 136 + ks * 32 + fq * 8);
      bf16x8 ak = *(const bf16x8*)(kb + (wave * 16 + fr) * 136 + ks * 32 + fq * 8);
#pragma unroll
      for (int j = 0; j < 4; ++j) {
        bf16x8 b = *(const bf16x8*)(kb + (j * 16 + fr) * 136 + ks * 32 + fq * 8);
        akk[j] = mfma16(ak, b, akk[j]);
        aqk[j] = mfma16(aq, b, aqk[j]);
      }
    }
#pragma unroll
    for (int j = 0; j < 4; ++j)
#pragma unroll
      for (int r = 0; r < 4; ++r) {
        const int row = wave * 16 + fq * 4 + r, col = j * 16 + fr;
        float dec = (col <= row) ? __expf(sG[row] - sG[col]) : 0.f;
        sAm[row * 68 + col] = (col < row) ? sBeta[row] * akk[j][r] * dec : 0.f;
        gAttn[row * 64 + col] = f2bf(aqk[j][r] * dec);
      }
  }
  __syncthreads();
#ifndef SKIP_SOLVE
  {
    float x[64];
    const u16* rsrc = tid < 128 ? vb + tid : kb + (tid - 128);
    const bool isw = tid >= 128;
#pragma unroll
    for (int l = 0; l < 64; ++l) {
      float sacc = bf2f(rsrc[l * 136]) * sBeta[l];
      if (isw) sacc *= sEG[l];
#pragma unroll
      for (int j0 = 0; j0 < l; j0 += 16) {
#pragma unroll
        for (int j = j0; j < (j0 + 16 < l ? j0 + 16 : l); ++j) sacc -= sAm[l * 68 + j] * x[j];
        asm volatile("" ::: "memory");
      }
      x[l] = sacc;
    }
    u16* dstc = tid < 128 ? gU + tid : gW + (tid - 128);
#pragma unroll
    for (int l = 0; l < 64; ++l) dstc[l * 128] = f2bf(x[l]);
  }
#endif
  const float Glast = sG[63];
  for (int e = tid; e < 8192; e += 256) {
    int l = e >> 7, k = e & 127;
    gQe[e] = f2bf(bf2f(qb[l * 136 + k]) * sEG[l]);
  }
  for (int e = tid; e < 8192; e += 256) {
    int k = e >> 6, l = e & 63;
    gKdT[e] = f2bf(bf2f(kb[l * 136 + k]) * __expf(Glast - sG[l]));
  }
  if (tid == 0) gScal[0] = __expf(Glast);
  if (c.last) {
    float* oc = st_out(p, O_PCONV, O_SCONV, layer, c.q, 3 * 1536);
    for (int e = tid; e < 1152; e += 256) {
      int j = e / 384, rem = e % 384, part = rem >> 7, ch = rem & 127;
      int col = part * 512 + h * 128 + ch;
      oc[j * 1536 + col] = bf2f(proj[(size_t)(c.row0 + c.Lv - 3 + j) * PP + col]);
    }
  }
}

__device__ __forceinline__ void prep_ml(const Params& p, int layer_, int ci, int h, unsigned char* smem) {
  const int layer = opaque_s(layer_);
  const int tid = opaque(threadIdx.x), lane = tid & 63, wave = tid >> 6, fr = lane & 15, fq = lane >> 4;
  const ChunkInfo c = chunk_info(ci);
  u16* qb = (u16*)smem;
  u16* kb = qb + 64 * 136;
  u16* vb = kb + 64 * 136;
  const u16* proj = (const u16*)(wsat(p, WS_PROJ));
  unsigned char* item = wsat(p, WS_PML) + (size_t)(ci * 4 + h) * ML_ITEM;
  u16* gQK = (u16*)item;
  u16* gKT = gQK + opaque_s(4096);
  u16* gVT = gKT + opaque_s(8192);
  float* gVec = (float*)(item + opaque_s(40960));

  __syncthreads();
  if (wave == 0) {
    float ig = NEGF, lf = 0.f;
    if (lane < c.Lv) {
      const u16* pr = proj + (size_t)(c.row0 + lane) * PP;
      ig = bf2f(pr[C_MLI + h]) + pin(p, 17)[layer * 4 + h];
      float x = bf2f(pr[C_MLF + h]) + pin(p, 18)[layer * 4 + h];
      lf = (x < -20.f) ? x : -log1pf(__expf(-x));
    }
    float b = lf;
#pragma unroll
    for (int d = 1; d < 64; d <<= 1) { float t = __shfl_up(b, d); if (lane >= d) b += t; }
    float pm = ig - b;
#pragma unroll
    for (int d = 1; d < 64; d <<= 1) { float t = __shfl_up(pm, d); if (lane >= d) pm = fmaxf(pm, t); }
    gVec[lane] = b; gVec[64 + lane] = ig; gVec[128 + lane] = b + pm;
  }
  for (int e = tid; e < 64 * 16 * 3; e += 256) {
    int part = e / 1024, rem = e % 1024, l = rem >> 4, seg = rem & 15;
    uint4 v = make_uint4(0, 0, 0, 0);
    if (l < c.Lv) v = *(const uint4*)(proj + (size_t)(c.row0 + l) * PP + C_MLQ + part * 512 + h * 128 + seg * 8);
    if (part == 1) {
      const float sc = 0.08838834764831845f;
      v.x = pack2(bf2f(v.x) * sc, bf2f(v.x >> 16) * sc);
      v.y = pack2(bf2f(v.y) * sc, bf2f(v.y >> 16) * sc);
      v.z = pack2(bf2f(v.z) * sc, bf2f(v.z >> 16) * sc);
      v.w = pack2(bf2f(v.w) * sc, bf2f(v.w >> 16) * sc);
    }
    u16* dst = part == 0 ? qb : (part == 1 ? kb : vb);
    *(uint4*)(dst + l * 136 + seg * 8) = v;
  }
  __syncthreads();
  {
    f32x4 aqk[4];
#pragma unroll
    for (int j = 0; j < 4; ++j) aqk[j] = zero4();
#pragma unroll
    for (int ks = 0; ks < 4; ++ks) {
      bf16x8 aq = *(const bf16x8*)(qb + (wave * 16 + fr) * 136 + ks * 32 + fq * 8);
#pragma unroll
      for (int j = 0; j < 4; ++j) {
        bf16x8 b = *(const bf16x8*)(kb + (j * 16 + fr) * 136 + ks * 32 + fq * 8);
        aqk[j] = mfma16(aq, b, aqk[j]);
      }
    }
#pragma unroll
    for (int j = 0; j < 4; ++j)
#pragma unroll
      for (int r = 0; r < 4; ++r) {
        const int row = wave * 16 + fq * 4 + r, col = j * 16 + fr;
        gQK[row * 64 + col] = f2bf(aqk[j][r]);
      }
  }
  for (int e = tid; e < 8192; e += 256) {
    int k = e >> 6, l = e & 63;
    gKT[e] = kb[l * 136 + k];
    gVT[e] = vb[l * 136 + k];
  }
}

__device__ __forceinline__ void seq_dn(const Params& p, int layer_, int q, int h, unsigned char* smem) {
  const int layer = opaque_s(layer_);
  const int tid = opaque(threadIdx.x), lane = tid & 63, wave = tid >> 6, fr = lane & 15, fq = lane >> 4;
  u16* sST = (u16*)smem + wave * (32 * 136);
  u16* sVT = (u16*)(smem + 34816) + wave * (32 * 72);
  float* sSS = (float*)(smem + 53248);
  const u16* proj = (const u16*)(wsat(p, WS_PROJ));
  u16* obr = (u16*)(wsat(p, WS_OBR));
  const float* normw = pin(p, 16) + layer * 128;
  f32x4 st[2][8];
  int nch, ci0;
  if (q < 8) { nch = 33; ci0 = q * 33; } else { nch = 1; ci0 = 264 + (q - 8); }
  if (q < 8) {
#pragma unroll
    for (int i = 0; i < 2; ++i)
#pragma unroll
      for (int j = 0; j < 8; ++j) st[i][j] = zero4();
  } else {
    const float* s0 = pin(p, 3) + ((size_t)(layer * 128 + (q - 8)) * 4 + h) * 16384;
#pragma unroll
    for (int i = 0; i < 2; ++i)
#pragma unroll
      for (int j = 0; j < 8; ++j) {
        float4 v = *(const float4*)(s0 + (j * 16 + fr) * 128 + wave * 32 + i * 16 + fq * 4);
        st[i][j][0] = v.x; st[i][j][1] = v.y; st[i][j][2] = v.z; st[i][j][3] = v.w;
      }
  }
#pragma unroll 1
  for (int cc = 0; cc < nch; ++cc) {
    const int ci = ci0 + cc;
    const ChunkInfo c = chunk_info(ci);
    const unsigned char* item = wsat(p, WS_PDN) + (size_t)(ci * 4 + h) * DN_ITEM;
    const u16* gU = (const u16*)item;
    const u16* gW = gU + opaque_s(8192);
    const u16* gQe = gW + opaque_s(8192);
    const u16* gKdT = gQe + opaque_s(8192);
    const u16* gAttn = gKdT + opaque_s(8192);
    const float eg = *(const float*)(item + opaque_s(73728));
    unsigned tv0 = 0, tv1 = 0, tv2 = 0, tv3 = 0;
    if (cc + 1 < nch) {
      const unsigned char* nb = item + DN_ITEM * 4 + (size_t)tid * 128;
      tv0 = *(const unsigned*)nb; tv1 = *(const unsigned*)(nb + 32768); tv2 = *(const unsigned*)(nb + 65536);
      tv3 = *(const unsigned*)((const unsigned char*)(proj + (size_t)(q * 2048 + cc * 64 + (tid >> 2)) * PP + C_DNZ + h * 128) + (tid & 1) * 128);
    }
    __syncthreads();
#pragma unroll
    for (int i = 0; i < 2; ++i)
#pragma unroll
      for (int j = 0; j < 8; ++j)
#pragma unroll
        for (int r = 0; r < 4; ++r) sST[(i * 16 + fq * 4 + r) * 136 + j * 16 + fr] = f2bf(st[i][j][r]);
    __syncthreads();
#pragma unroll 1
    for (int hf = 0; hf < 2; ++hf) {
      f32x4 vn[2][2];
#pragma unroll
      for (int i = 0; i < 2; ++i) { vn[i][0] = zero4(); vn[i][1] = zero4(); }
#pragma unroll
      for (int ks = 0; ks < 4; ++ks) {
        bf16x8 b0 = *(const bf16x8*)(sST + (fr) * 136 + ks * 32 + fq * 8);
        bf16x8 b1 = *(const bf16x8*)(sST + (16 + fr) * 136 + ks * 32 + fq * 8);
#pragma unroll
        for (int i = 0; i < 2; ++i) {
          bf16x8 a = ldg8(gW + ((hf * 2 + i) * 16 + fr) * 128 + ks * 32 + fq * 8);
          vn[i][0] = mfma16(a, b0, vn[i][0]);
          vn[i][1] = mfma16(a, b1, vn[i][1]);
        }
      }
#pragma unroll
      for (int i = 0; i < 2; ++i)
#pragma unroll
        for (int jn = 0; jn < 2; ++jn) {
          const int nl = jn * 16 + fr;
          float v[4];
#pragma unroll
          for (int r = 0; r < 4; ++r) {
            const int l = (hf * 2 + i) * 16 + fq * 4 + r;
            v[r] = bf2f(gU[l * 128 + wave * 32 + nl]) - vn[i][jn][r];
          }
          uint2 pk; pk.x = pack2(v[0], v[1]); pk.y = pack2(v[2], v[3]);
          *(uint2*)(sVT + nl * 72 + (hf * 2 + i) * 16 + fq * 4) = pk;
        }
    }
    __syncthreads();
#pragma unroll 1
    for (int hf = 0; hf < 2; ++hf) {
      f32x4 o[2][2];
#pragma unroll
      for (int i = 0; i < 2; ++i) { o[i][0] = zero4(); o[i][1] = zero4(); }
#pragma unroll
      for (int ks = 0; ks < 4; ++ks) {
        bf16x8 b0 = *(const bf16x8*)(sST + (fr) * 136 + ks * 32 + fq * 8);
        bf16x8 b1 = *(const bf16x8*)(sST + (16 + fr) * 136 + ks * 32 + fq * 8);
#pragma unroll
        for (int i = 0; i < 2; ++i) {
          bf16x8 a = ldg8(gQe + ((hf * 2 + i) * 16 + fr) * 128 + ks * 32 + fq * 8);
          o[i][0] = mfma16(a, b0, o[i][0]);
          o[i][1] = mfma16(a, b1, o[i][1]);
        }
      }
#pragma unroll
      for (int ks = 0; ks < 2; ++ks) {
        bf16x8 b0 = *(const bf16x8*)(sVT + (fr) * 72 + ks * 32 + fq * 8);
        bf16x8 b1 = *(const bf16x8*)(sVT + (16 + fr) * 72 + ks * 32 + fq * 8);
#pragma unroll
        for (int i = 0; i < 2; ++i) {
          bf16x8 a = ldg8(gAttn + ((hf * 2 + i) * 16 + fr) * 64 + ks * 32 + fq * 8);
          o[i][0] = mfma16(a, b0, o[i][0]);
          o[i][1] = mfma16(a, b1, o[i][1]);
        }
      }
#pragma unroll
      for (int i = 0; i < 2; ++i)
#pragma unroll
        for (int r = 0; r < 4; ++r) {
          float ss = o[i][0][r] * o[i][0][r] + o[i][1][r] * o[i][1][r];
          ss += __shfl_xor(ss, 1); ss += __shfl_xor(ss, 2); ss += __shfl_xor(ss, 4); ss += __shfl_xor(ss, 8);
          if (fr == 0) sSS[wave * 64 + (hf * 2 + i) * 16 + fq * 4 + r] = ss;
        }
      __syncthreads();
#pragma unroll
      for (int i = 0; i < 2; ++i)
#pragma unroll
        for (int r = 0; r < 4; ++r) {
          const int l = (hf * 2 + i) * 16 + fq * 4 + r;
          if (l < c.Lv) {
            float tot = sSS[l] + sSS[64 + l] + sSS[128 + l] + sSS[192 + l];
            float rstd = rsqrtf(tot * (1.f / 128.f) + EPSF);
#pragma unroll
            for (int jn = 0; jn < 2; ++jn) {
              const int n = wave * 32 + jn * 16 + fr;
              float z = bf2f(proj[(size_t)(c.row0 + l) * PP + C_DNZ + h * 128 + n]);
              float val = o[i][jn][r] * rstd * normw[n] * siluf_(z);
              obr[(size_t)(c.row0 + l) * 1536 + h * 128 + n] = f2bf(val);
            }
          }
        }
    }
#pragma unroll
    for (int i = 0; i < 2; ++i)
#pragma unroll
      for (int j = 0; j < 8; ++j) st[i][j] *= eg;
#pragma unroll
    for (int ks = 0; ks < 2; ++ks) {
      bf16x8 a0 = *(const bf16x8*)(sVT + (fr) * 72 + ks * 32 + fq * 8);
      bf16x8 a1 = *(const bf16x8*)(sVT + (16 + fr) * 72 + ks * 32 + fq * 8);
#pragma unroll
      for (int j = 0; j < 8; ++j) {
        bf16x8 b = ldg8(gKdT + (j * 16 + fr) * 64 + ks * 32 + fq * 8);
        st[0][j] = mfma16(a0, b, st[0][j]);
        st[1][j] = mfma16(a1, b, st[1][j]);
      }
    }
    asm volatile("" :: "v"(tv0), "v"(tv1), "v"(tv2), "v"(tv3));
  }
  float* so = st_out(p, O_PDNS, O_SDNS, layer, q, 65536) + (size_t)h * 16384;
#pragma unroll
  for (int i = 0; i < 2; ++i)
#pragma unroll
    for (int j = 0; j < 8; ++j) {
      float4 v; v.x = st[i][j][0]; v.y = st[i][j][1]; v.z = st[i][j][2]; v.w = st[i][j][3];
      *(float4*)(so + (j * 16 + fr) * 128 + wave * 32 + i * 16 + fq * 4) = v;
    }
}

__device__ __forceinline__ void seq_ml(const Params& p, int layer_, int q, int h, unsigned char* smem) {
  const int layer = opaque_s(layer_);
  const int tid = opaque(threadIdx.x), lane = tid & 63, wave = tid >> 6, fr = lane & 15, fq = lane >> 4;
  u16* sCT = (u16*)smem + wave * (32 * 136);
  float* sSS = (float*)(smem + 34816);
  float* sN = sSS + 256;
  float* sB = sN + 128;
  float* sIg = sB + 64;
  float* sMt = sIg + 64;
  float* sWi = sMt + 64;
  float* sWs = sWi + 64;
  float* sQn = sWs + 64;
  float* sDen = sQn + 64;
  const u16* proj = (const u16*)(wsat(p, WS_PROJ));
  u16* obr = (u16*)(wsat(p, WS_OBR));
  const float* normw = pin(p, 19) + layer * 128;
  f32x4 st[2][8];
  int nch, ci0;
  float m;
  if (q < 8) { nch = 33; ci0 = q * 33; } else { nch = 1; ci0 = 264 + (q - 8); }
  __syncthreads();
  if (q < 8) {
#pragma unroll
    for (int i = 0; i < 2; ++i)
#pragma unroll
      for (int j = 0; j < 8; ++j) st[i][j] = zero4();
    if (tid < 128) sN[tid] = 0.f;
    m = NEGF;
  } else {
    const float* s0 = pin(p, 4) + ((size_t)(layer * 128 + (q - 8)) * 4 + h) * 16384;
#pragma unroll
    for (int i = 0; i < 2; ++i)
#pragma unroll
      for (int j = 0; j < 8; ++j) {
        float4 v = *(const float4*)(s0 + (j * 16 + fr) * 128 + wave * 32 + i * 16 + fq * 4);
        st[i][j][0] = v.x; st[i][j][1] = v.y; st[i][j][2] = v.z; st[i][j][3] = v.w;
      }
    if (tid < 128) sN[tid] = pin(p, 5)[((size_t)(layer * 128 + (q - 8)) * 4 + h) * 128 + tid];
    m = pin(p, 6)[(size_t)(layer * 128 + (q - 8)) * 4 + h];
  }
#pragma unroll 1
  for (int cc = 0; cc < nch; ++cc) {
    const int ci = ci0 + cc;
    const ChunkInfo c = chunk_info(ci);
    const unsigned char* item = wsat(p, WS_PML) + (size_t)(ci * 4 + h) * ML_ITEM;
    const u16* gQK = (const u16*)item;
    const u16* gKT = gQK + opaque_s(4096);
    const u16* gVT = gKT + opaque_s(8192);
    const float* gVec = (const float*)(item + opaque_s(40960));
    const float blast = gVec[63];
    const float m_new = fmaxf(blast + m, gVec[128 + 63]);
    const float carry = __expf(blast + m - m_new);
    unsigned tv0 = 0, tv1 = 0, tv2 = 0, tv3 = 0;
    if (cc + 1 < nch) {
      const unsigned char* nb = item + ML_ITEM * 4 + (size_t)tid * 128;
      tv0 = *(const unsigned*)nb; tv1 = *(const unsigned*)(nb + 9216);
      const int rrow = tid >> 2, part = tid & 3;
      const int col = (part == 0) ? C_MLQ : (part == 1) ? C_MLO : C_MLZ;
      const unsigned char* b = (const unsigned char*)(proj + (size_t)(q * 2048 + cc * 64 + rrow) * PP + col + h * 128);
      tv2 = *(const unsigned*)b; tv3 = *(const unsigned*)(b + 128);
    }
    __syncthreads();
#pragma unroll
    for (int i = 0; i < 2; ++i)
#pragma unroll
      for (int j = 0; j < 8; ++j)
#pragma unroll
        for (int r = 0; r < 4; ++r) sCT[(i * 16 + fq * 4 + r) * 136 + j * 16 + fr] = f2bf(st[i][j][r]);
    if (tid < 64) {
      float b = gVec[tid], ig = gVec[64 + tid], lm = gVec[128 + tid];
      float mt = fmaxf(b + m, lm);
      sB[tid] = b; sIg[tid] = ig; sMt[tid] = mt;
      sWi[tid] = __expf(b + m - mt);
      sWs[tid] = __expf(blast - b + ig - m_new);
    }
    {
      const int l = tid >> 2, part = tid & 3;
      float acc = 0.f;
      if (l < c.Lv) {
        const u16* qp = proj + (size_t)(c.row0 + l) * PP + C_MLQ + h * 128 + part * 32;
#pragma unroll
        for (int s4 = 0; s4 < 4; ++s4) {
          uint4 v = *(const uint4*)(qp + s4 * 8);
          const float* nn = sN + part * 32 + s4 * 8;
          acc += bf2f(v.x) * nn[0] + bf2f(v.x >> 16) * nn[1] + bf2f(v.y) * nn[2] + bf2f(v.y >> 16) * nn[3] +
                 bf2f(v.z) * nn[4] + bf2f(v.z >> 16) * nn[5] + bf2f(v.w) * nn[6] + bf2f(v.w >> 16) * nn[7];
        }
      }
      acc += __shfl_xor(acc, 1); acc += __shfl_xor(acc, 2);
      if (part == 0) sQn[l] = acc;
    }
    __syncthreads();
#pragma unroll 1
    for (int hf = 0; hf < 2; ++hf) {
      f32x4 o[2][2];
#pragma unroll
      for (int i = 0; i < 2; ++i) { o[i][0] = zero4(); o[i][1] = zero4(); }
#pragma unroll
      for (int ks = 0; ks < 4; ++ks) {
        bf16x8 b0 = *(const bf16x8*)(sCT + (fr) * 136 + ks * 32 + fq * 8);
        bf16x8 b1 = *(const bf16x8*)(sCT + (16 + fr) * 136 + ks * 32 + fq * 8);
#pragma unroll
        for (int i = 0; i < 2; ++i) {
          const int l = (hf * 2 + i) * 16 + fr;
          bf16x8 a = zero8();
          if (l < c.Lv) a = ldg8(proj + (size_t)(c.row0 + l) * PP + C_MLQ + h * 128 + ks * 32 + fq * 8);
          o[i][0] = mfma16(a, b0, o[i][0]);
          o[i][1] = mfma16(a, b1, o[i][1]);
        }
      }
#pragma unroll
      for (int i = 0; i < 2; ++i)
#pragma unroll
        for (int r = 0; r < 4; ++r) {
          const float wi = sWi[(hf * 2 + i) * 16 + fq * 4 + r];
          o[i][0][r] *= wi; o[i][1][r] *= wi;
        }
      float rs[2] = {0.f, 0.f};
#pragma unroll
      for (int ks = 0; ks < 2; ++ks) {
        bf16x8 b0 = ldg8(gVT + (wave * 32 + fr) * 64 + ks * 32 + fq * 8);
        bf16x8 b1 = ldg8(gVT + (wave * 32 + 16 + fr) * 64 + ks * 32 + fq * 8);
#pragma unroll
        for (int i = 0; i < 2; ++i) {
          const int fr_o = opaque(fr), fq_o = opaque(fq);
          const int l = (hf * 2 + i) * 16 + fr_o;
          bf16x8 qk = ldg8(gQK + l * 64 + ks * 32 + fq_o * 8);
          const float bl = sB[l], mtl = sMt[l];
          bf16x8 a;
#pragma unroll
          for (int e = 0; e < 8; ++e) {
            const int jj = ks * 32 + fq_o * 8 + e;
            float w = (jj <= l) ? __expf(bl - sB[jj] + sIg[jj] - mtl) : 0.f;
            float sv = bf2f((unsigned)(u16)qk[e]) * w;
            rs[i] += sv;
            a[e] = (short)f2bf(sv);
          }
          o[i][0] = mfma16(a, b0, o[i][0]);
          o[i][1] = mfma16(a, b1, o[i][1]);
        }
      }
#pragma unroll
      for (int i = 0; i < 2; ++i) {
        float v = rs[i];
        v += __shfl_xor(v, 16); v += __shfl_xor(v, 32);
        const int l = (hf * 2 + i) * 16 + fr;
        if (fq == 0) sDen[wave * 64 + l] = sWi[l] * sQn[l] + v;
      }
      __syncthreads();
#pragma unroll
      for (int i = 0; i < 2; ++i)
#pragma unroll
        for (int r = 0; r < 4; ++r) {
          const int l = (hf * 2 + i) * 16 + fq * 4 + r;
          float den = fmaxf(fabsf(sDen[wave * 64 + l]), __expf(-sMt[l]));
          float inv = 1.f / den;
          o[i][0][r] *= inv; o[i][1][r] *= inv;
          float ss = o[i][0][r] * o[i][0][r] + o[i][1][r] * o[i][1][r];
          ss += __shfl_xor(ss, 1); ss += __shfl_xor(ss, 2); ss += __shfl_xor(ss, 4); ss += __shfl_xor(ss, 8);
          if (fr == 0) sSS[wave * 64 + l] = ss;
        }
      __syncthreads();
#pragma unroll
      for (int i = 0; i < 2; ++i)
#pragma unroll
        for (int r = 0; r < 4; ++r) {
          const int l = (hf * 2 + i) * 16 + fq * 4 + r;
          if (l < c.Lv) {
            float tot = sSS[l] + sSS[64 + l] + sSS[128 + l] + sSS[192 + l];
            float rstd = rsqrtf(tot * (1.f / 128.f) + EPSF);
#pragma unroll
            for (int jn = 0; jn < 2; ++jn) {
              const int n = wave * 32 + jn * 16 + fr;
              const u16* pr = proj + (size_t)(c.row0 + l) * PP;
              float og = bf2f(pr[C_MLO + h * 128 + n]);
              float z = bf2f(pr[C_MLZ + h * 128 + n]);
              float val = o[i][jn][r] * rstd * normw[n] * sigmoidf_(og) * siluf_(z);
              obr[(size_t)(c.row0 + l) * 1536 + 512 + h * 128 + n] = f2bf(val);
            }
          }
        }
    }
    __syncthreads();
    if (tid < 128) {
      float acc = carry * sN[tid];
      const u16* kr = gKT + tid * 64;
#pragma unroll
      for (int s8 = 0; s8 < 8; ++s8) {
        uint4 v = *(const uint4*)(kr + s8 * 8);
        const float* ww = sWs + s8 * 8;
        acc += bf2f(v.x) * ww[0] + bf2f(v.x >> 16) * ww[1] + bf2f(v.y) * ww[2] + bf2f(v.y >> 16) * ww[3] +
               bf2f(v.z) * ww[4] + bf2f(v.z >> 16) * ww[5] + bf2f(v.w) * ww[6] + bf2f(v.w >> 16) * ww[7];
      }
      sN[tid] = acc;
    }
#pragma unroll
    for (int i = 0; i < 2; ++i)
#pragma unroll
      for (int j = 0; j < 8; ++j) st[i][j] *= carry;
#pragma unroll
    for (int ks = 0; ks < 2; ++ks) {
      bf16x8 a[2];
#pragma unroll
      for (int i = 0; i < 2; ++i) {
        bf16x8 raw = ldg8(gVT + (wave * 32 + i * 16 + fr) * 64 + ks * 32 + fq * 8);
#pragma unroll
        for (int e = 0; e < 8; ++e)
          a[i][e] = (short)f2bf(bf2f((unsigned)(u16)raw[e]) * sWs[ks * 32 + fq * 8 + e]);
      }
#pragma unroll
      for (int j = 0; j < 8; ++j) {
        bf16x8 b = ldg8(gKT + (j * 16 + fr) * 64 + ks * 32 + fq * 8);
        st[0][j] = mfma16(a[0], b, st[0][j]);
        st[1][j] = mfma16(a[1], b, st[1][j]);
      }
    }
    m = m_new;
    asm volatile("" :: "v"(tv0), "v"(tv1), "v"(tv2), "v"(tv3));
  }
  __syncthreads();
  float* so = st_out(p, O_PMLC, O_SMLC, layer, q, 65536) + (size_t)h * 16384;
#pragma unroll
  for (int i = 0; i < 2; ++i)
#pragma unroll
    for (int j = 0; j < 8; ++j) {
      float4 v; v.x = st[i][j][0]; v.y = st[i][j][1]; v.z = st[i][j][2]; v.w = st[i][j][3];
      *(float4*)(so + (j * 16 + fr) * 128 + wave * 32 + i * 16 + fq * 4) = v;
    }
  if (tid < 128) st_out(p, O_PMLN, O_SMLN, layer, q, 512)[h * 128 + tid] = sN[tid];
  if (tid == 0) st_out(p, O_PMLM, O_SMLM, layer, q, 4)[h] = m;
}

__device__ __forceinline__ void s5_chain(const Params& p, int layer_, int q, int gq, unsigned char* smem) {
  const int layer = opaque_s(layer_);
  const int tid = opaque(threadIdx.x), lane = tid & 63, wave = tid >> 6, fr = lane & 15, fq = lane >> 4;
  const int g = gq * 4 + wave;
  float* sBu = (float*)smem + wave * (16 * 132);
  float* sHf = (float*)(smem + 33792) + wave * (16 * 132);
  const u16* proj = (const u16*)(wsat(p, WS_PROJ));
  u16* y5g = (u16*)(wsat(p, WS_Y5G));
  const float* lre = pin(p, 20) + (size_t)(layer * 32 + g) * 64;
  const float* lim = pin(p, 21) + (size_t)(layer * 32 + g) * 64;
  const float dt = __expf(pin(p, 22)[layer * 32 + g]);
  float lbr, lbi;
  {
    float zr = lre[lane] * dt, zi = lim[lane] * dt;
    float e = __expf(zr);
    lbr = e * __cosf(zi); lbi = e * __sinf(zi);
  }
  bf16x8 bB[8];
#pragma unroll
  for (int j = 0; j < 8; ++j) {
    const int pp = j * 16 + fr, ps = pp & 63, isim = pp >> 6;
    float ar = lre[ps], ai = lim[ps];
    float zr = ar * dt, zi = ai * dt;
    float e = __expf(zr);
    float br_ = e * __cosf(zi) - 1.f, bi_ = e * __sinf(zi);
    float den = ar * ar + ai * ai;
    float cr = (br_ * ar + bi_ * ai) / den;
    float cim = (bi_ * ar - br_ * ai) / den;
    bB[j] = zero8();
    if (fq < 2) {
      const float* bre = pin(p, 23) + ((size_t)(layer * 32 + g) * 64 + ps) * 16 + fq * 8;
      const float* bim = pin(p, 24) + ((size_t)(layer * 32 + g) * 64 + ps) * 16 + fq * 8;
#pragma unroll
      for (int e2 = 0; e2 < 8; ++e2) {
        float v = isim ? (cr * bim[e2] + cim * bre[e2]) : (cr * bre[e2] - cim * bim[e2]);
        bB[j][e2] = (short)f2bf(v);
      }
    }
  }
  bf16x8 bC[4];
#pragma unroll
  for (int ks = 0; ks < 4; ++ks) {
#pragma unroll
    for (int e2 = 0; e2 < 8; ++e2) {
      const int pp = ks * 32 + fq * 8 + e2;
      float v = (pp < 64) ? pin(p, 25)[((size_t)(layer * 32 + g) * 16 + fr) * 64 + pp]
                          : -pin(p, 26)[((size_t)(layer * 32 + g) * 16 + fr) * 64 + (pp - 64)];
      bC[ks][e2] = (short)f2bf(v);
    }
  }
  const float dcoef = pin(p, 27)[layer * 512 + g * 16 + fr];
  float hr = 0.f, hi = 0.f;
  int nst;
  if (q < 8) nst = 129;
  else {
    nst = 1;
    hr = pin(p, 7)[((size_t)(layer * 128 + (q - 8)) * 32 + g) * 64 + lane];
    hi = pin(p, 8)[((size_t)(layer * 128 + (q - 8)) * 32 + g) * 64 + lane];
  }
  auto s5_rows = [&](int stp_, int& row0_, int& nv_) {
    if (q < 8) { nv_ = 16; row0_ = (stp_ == 0) ? (ROW_META0 + q * 16) : (q * 2048 + (stp_ - 1) * 16); }
    else { nv_ = 8; row0_ = ROW_SAMPLE0 + (q - 8) * 8; }
  };
  auto s5_load = [&](int row0_, int nv_) {
    bf16x8 a_ = zero8();
    if (fq < 2 && fr < nv_) a_ = ldg8(proj + (size_t)(row0_ + fr) * PP + C_S5U + g * 16 + fq * 8);
    return a_;
  };
  bf16x8 au_next;
  { int r0, n0_; s5_rows(0, r0, n0_); au_next = s5_load(r0, n0_); }
#pragma unroll 1
  for (int stp = 0; stp < nst; ++stp) {
    int row0, nv;
    s5_rows(stp, row0, nv);
    bf16x8 au = au_next;
    if (stp + 1 < nst) { int r1, n1; s5_rows(stp + 1, r1, n1); au_next = s5_load(r1, n1); }
    __syncthreads();
#pragma unroll
    for (int j = 0; j < 8; ++j) {
      f32x4 acc = zero4();
      acc = mfma16(au, bB[j], acc);
      asm volatile("s_nop 15\n\ts_nop 15" : "+v"(acc));
#pragma unroll
      for (int r = 0; r < 4; ++r) sBu[(fq * 4 + r) * 132 + j * 16 + fr] = acc[r];
    }
    __syncthreads();
    for (int t = 0; t < nv; ++t) {
      float br = sBu[t * 132 + lane], bi = sBu[t * 132 + 64 + lane];
      float nr = lbr * hr - lbi * hi + br;
      float ni = lbr * hi + lbi * hr + bi;
      hr = nr; hi = ni;
      sHf[t * 132 + lane] = hr;
      sHf[t * 132 + 64 + lane] = hi;
    }
    for (int t = nv; t < 16; ++t) { sHf[t * 132 + lane] = 0.f; sHf[t * 132 + 64 + lane] = 0.f; }
    __syncthreads();
    f32x4 y = zero4();
#pragma unroll
    for (int ks = 0; ks < 4; ++ks) {
      const float4 h0 = *(const float4*)(sHf + fr * 132 + ks * 32 + fq * 8);
      const float4 h1 = *(const float4*)(sHf + fr * 132 + ks * 32 + fq * 8 + 4);
      bf16x8 a;
      a[0] = (short)f2bf(h0.x); a[1] = (short)f2bf(h0.y); a[2] = (short)f2bf(h0.z); a[3] = (short)f2bf(h0.w);
      a[4] = (short)f2bf(h1.x); a[5] = (short)f2bf(h1.y); a[6] = (short)f2bf(h1.z); a[7] = (short)f2bf(h1.w);
      y = mfma16(a, bC[ks], y);
    }
    asm volatile("s_nop 15\n\ts_nop 15" : "+v"(y));
#pragma unroll
    for (int r = 0; r < 4; ++r) {
      const int t = fq * 4 + r;
      if (t < nv) {
#if S5_SYNTH
        float u = bf2f(f2bf((float)((((row0 + t) * 31 + (g * 16 + fr) * 7) & 255)) * (1.f / 256.f) - 0.5f));
#else
        float u = bf2f(proj[(size_t)(row0 + t) * PP + C_S5U + g * 16 + fr]);
#endif
        const float dco = pin(p, 27)[layer * 512 + g * 16 + fr];
        float v = y[r] + dco * u;
        float inner = 0.7978845608028654f * (v + 0.044715f * v * v * v);
        float th = 1.f - 2.f / (1.f + __expf(2.f * inner));
        float ge = 0.5f * v * (1.f + th);
#if S5_SYNTH == 2
        ge = (float)((((row0 + t) * 13 + (g * 16 + fr) * 5) & 127)) * 0.01f;
#endif
#if S5_SYNTH == 5
        ge = sBu[t * 132 + fr * 8] + sBu[t * 132 + fr * 8 + 5];
#endif
#if S5_SYNTH == 6
        ge = bf2f((unsigned)(u16)bB[fr & 7][r]) + lbr + bf2f((unsigned)(u16)bC[r][fr & 7]);
#endif
#if S5_SYNTH == 4
        ge = sHf[t * 132 + fr * 8] + sHf[t * 132 + fr * 8 + 3];
#endif
#if S5_SYNTH == 3
        ge = y[r];
#endif
        y5g[(size_t)(row0 + t) * 512 + g * 16 + fr] = f2bf(ge);
      }
    }
  }
  st_out(p, O_PS5R, O_SS5R, layer, q, 2048)[g * 64 + lane] = hr;
  st_out(p, O_PS5I, O_SS5I, layer, q, 2048)[g * 64 + lane] = hi;
}


__device__ __forceinline__ void phase_xnorm(const Params& p, int bid_, int G_) {
  const int bid = opaque_s(bid_), G = opaque_s(G_);
  const int tidf = opaque(threadIdx.x);
  const int lane = tidf & 63, wave = tidf >> 6;
  for (int r = bid * 4 + wave; r < MROWS; r += G * 4) {
    const float4* xr = (const float4*)xrow(p, r);
    float4 v[4];
    float ss = 0.f;
#pragma unroll
    for (int i = 0; i < 4; ++i) {
      v[i] = xr[i * 64 + lane];
      ss += v[i].x * v[i].x + v[i].y * v[i].y + v[i].z * v[i].z + v[i].w * v[i].w;
    }
#pragma unroll
    for (int d = 32; d >= 1; d >>= 1) ss += __shfl_xor(ss, d);
    const float rstd = rsqrtf(ss * (1.f / 1024.f) + EPSF);
    uint2* dst = (uint2*)xnrow_fwd(p, r);
#pragma unroll
    for (int i = 0; i < 4; ++i) {
      uint2 o;
      o.x = pack2(v[i].x * rstd, v[i].y * rstd);
      o.y = pack2(v[i].z * rstd, v[i].w * rstd);
      dst[i * 64 + lane] = o;
    }
  }
}
__device__ __forceinline__ void phase_gemm1(const Params& p, int layer_, unsigned char* smem, int bid_, int G_) {
  const int layer = opaque_s(layer_), bid = opaque_s(bid_), G = opaque_s(G_);
  for (int t = bid; t < MT * 45; t += G) gemm_in_tile<0>(p, layer, t / 45, t % 45, smem);
}
__device__ __forceinline__ void phase2(const Params& p, int layer_, unsigned char* smem, int bid_, int G_) {
  const int layer = opaque_s(layer_), bid = opaque_s(bid_), G = opaque_s(G_);
  const int nshort = 1568 + 1568 + 1024;
  for (int it0 = bid; it0 < 64 + nshort; it0 += (bid < 64 ? (1 << 28) : G - 64)) {
    const int it = it0 - 64;
    int kind, a, b;
    if (it0 < 64) { kind = 2; a = it0 >> 3; b = it0 & 7; }
    else if (it < 1568) { kind = 0; a = it >> 2; b = it & 3; }
    else if (it < 3136) { kind = 1; a = (it - 1568) >> 2; b = (it - 1568) & 3; }
    else { kind = 2; a = 8 + ((it - 3136) >> 3); b = (it - 3136) & 7; }
#ifndef SKIP_A
    if (kind == 0) prep_dn(p, layer, a, b, smem);
#endif
#ifndef SKIP_B
    if (kind == 1) prep_ml(p, layer, a, b, smem);
#endif
#ifndef SKIP_C
    if (kind == 2) s5_chain(p, layer, a, b, smem);
#endif
  }
}
__device__ __forceinline__ void phase3(const Params& p, int layer_, unsigned char* smem, int bid_, int G_) {
  const int layer = opaque_s(layer_), bid = opaque_s(bid_), G = opaque_s(G_);
  const int nshort = 512 + 512 + MT * 4;
  for (int it0 = bid; it0 < 64 + nshort; it0 += (bid < 64 ? (1 << 28) : G - 64)) {
    const int it = it0 - 64;
    int kind, a, b;
    if (it0 < 32) { kind = 0; a = it0 >> 2; b = it0 & 3; }
    else if (it0 < 64) { kind = 1; a = (it0 - 32) >> 2; b = it0 & 3; }
    else if (it < 512) { kind = 0; a = 8 + (it >> 2); b = it & 3; }
    else if (it < 1024) { kind = 1; a = 8 + ((it - 512) >> 2); b = it & 3; }
    else { kind = 2; a = (it - 1024) >> 2; b = (it - 1024) & 3; }
#ifndef SKIP_A
    if (kind == 0) seq_dn(p, layer, a, b, smem);
#endif
#ifndef SKIP_B
    if (kind == 1) seq_ml(p, layer, a, b, smem);
#endif
#ifndef SKIP_C
    if (kind == 2) gemm_glu_tile(p, layer, a, b, smem);
#endif
  }
}
__device__ __forceinline__ void phase_gates(const Params& p, int layer_, unsigned char* smem, int bid_, int G_) {
  const int layer = opaque_s(layer_), bid = opaque_s(bid_), G = opaque_s(G_);
  for (int t = bid; t < MT * 24; t += G) gemm_in_tile<1>(p, layer, t / 24, t % 24, smem);
}
__device__ __forceinline__ void phase_mix(const Params& p, int layer_, unsigned char* smem, int bid_, int G_) {
  const int layer = opaque_s(layer_), bid = opaque_s(bid_), G = opaque_s(G_);
  for (int t = bid; t < MT * 16; t += G) gemm_mix_tile(p, layer, t >> 4, t & 15, smem);
}
__device__ __forceinline__ void phase_out(const Params& p, int layer_, unsigned char* smem, int bid_, int G_) {
  const int layer = opaque_s(layer_), bid = opaque_s(bid_), G = opaque_s(G_);
  for (int t = bid; t < MT * 8; t += G) gemm_out_tile(p, layer, t >> 3, t & 7, smem);
}
__device__ __forceinline__ void phase_final(const Params& p, int bid, int G) {
  const int tidf = opaque(threadIdx.x); const int lane = tidf & 63, wave = tidf >> 6;
  for (int r = bid * 4 + wave; r < ROW_META0; r += G * 4) {
    float4* xr = (float4*)(pout(p) + (size_t)r * 1024);
    float4 v[4];
    float ss = 0.f;
#pragma unroll
    for (int i = 0; i < 4; ++i) {
      v[i] = xr[i * 64 + lane];
      ss += v[i].x * v[i].x + v[i].y * v[i].y + v[i].z * v[i].z + v[i].w * v[i].w;
    }
#pragma unroll
    for (int d = 32; d >= 1; d >>= 1) ss += __shfl_xor(ss, d);
    float rstd = rsqrtf(ss * (1.f / 1024.f) + EPSF);
#pragma unroll
    for (int i = 0; i < 4; ++i) {
      float4 w = ((const float4*)pin(p, 34))[i * 64 + lane];
      v[i].x *= rstd * w.x; v[i].y *= rstd * w.y; v[i].z *= rstd * w.z; v[i].w *= rstd * w.w;
      xr[i * 64 + lane] = v[i];
    }
  }
}

#ifndef SYS_FENCE
#define SYS_FENCE 0
#endif

__device__ __forceinline__ void gsync(cg::grid_group& grid) {
#if SYS_FENCE
  asm volatile("s_waitcnt vmcnt(0) lgkmcnt(0)" ::: "memory");
  __syncthreads();
  if (threadIdx.x == 0) {
    __builtin_amdgcn_fence(__ATOMIC_RELEASE, "");
    asm volatile("s_waitcnt vmcnt(0)" ::: "memory");
  }
  __syncthreads();
#endif
  grid.sync();
#if SYS_FENCE
  if (threadIdx.x == 0) {
    __builtin_amdgcn_fence(__ATOMIC_ACQUIRE, "");
    asm volatile("s_waitcnt vmcnt(0)" ::: "memory");
  }
  __syncthreads();
#endif
}
__global__ void __launch_bounds__(256) mega_kernel(Params p) {
  __shared__ __attribute__((aligned(16))) unsigned char smem[SMEM_BYTES];
  cg::grid_group grid = cg::this_grid();
  const int bid = blockIdx.x, G = gridDim.x;
  phase0(p, smem, bid, G);
  gsync(grid);
  for (int layer = 0; layer < DEPTH_; ++layer) {
#pragma unroll 1
    for (int st = 0; st < 8; ++st) {
      if (st == 0 || st == 4) phase_xnorm(p, bid, G);
      else if (st == 1) phase_gemm1(p, layer, smem, bid, G);
      else if (st == 2) phase2(p, layer, smem, bid, G);
      else if (st == 3) phase3(p, layer, smem, bid, G);
      else if (st == 5) phase_gates(p, layer, smem, bid, G);
      else if (st == 6) phase_mix(p, layer, smem, bid, G);
      else phase_out(p, layer, smem, bid, G);
      gsync(grid);
    }
  }
  phase_final(p, bid, G);
}

#if MULTI_LAUNCH
template <int PH>
__global__ void __launch_bounds__(256) phase_kernel(Params p, int layer) {
  __shared__ __attribute__((aligned(16))) unsigned char smem[SMEM_BYTES];
  const int bid = blockIdx.x, G = gridDim.x;
  if (PH == 0) phase0(p, smem, bid, G);
  if (PH == 1) phase_gemm1(p, layer, smem, bid, G);
  if (PH == 2) phase2(p, layer, smem, bid, G);
  if (PH == 3) phase3(p, layer, smem, bid, G);
  if (PH == 4) phase_gates(p, layer, smem, bid, G);
  if (PH == 5) phase_mix(p, layer, smem, bid, G);
  if (PH == 6) phase_out(p, layer, smem, bid, G);
  if (PH == 7) phase_final(p, bid, G);
}
#endif


#ifndef DIAG_SELF
#define DIAG_SELF 0
#endif
#if DIAG_SELF
__device__ __forceinline__ void phase_csum(const void* buf, size_t nwords, unsigned long long* dst, int bid, int G) {
  const unsigned* w = (const unsigned*)buf;
  unsigned long long s = 0;
  for (size_t i = (size_t)bid * 256 + threadIdx.x; i < nwords; i += (size_t)G * 256)
    s += (unsigned long long)w[i] * (unsigned long long)((i & 0xffff) + 1);
  atomicAdd(dst, s);
}
__device__ __forceinline__ void phase_csum_items(const void* buf, int nitems, size_t item_words, size_t valid_words, unsigned long long* dst, int bid, int G) {
  const unsigned* w = (const unsigned*)buf;
  unsigned long long s = 0;
  const size_t total = (size_t)nitems * valid_words;
  for (size_t i = (size_t)bid * 256 + threadIdx.x; i < total; i += (size_t)G * 256) {
    size_t it = i / valid_words, o = i % valid_words;
    s += (unsigned long long)w[it * item_words + o] * (unsigned long long)((i & 0xffff) + 1);
  }
  atomicAdd(dst, s);
}
__global__ void __launch_bounds__(256) diag_kernel(Params p) {
  unsigned long long* cs = (unsigned long long*)(wsat(p, WS_END));
  __shared__ __attribute__((aligned(16))) unsigned char smem[SMEM_BYTES];
  cg::grid_group grid = cg::this_grid();
  const int bid = blockIdx.x, G = gridDim.x;
  if (bid == 0) cs[threadIdx.x] = 0ull;
  for (int pass = 0; pass < 2; ++pass) {
    unsigned long long* c0 = cs + pass * 32;
    {
      const size_t insz[35] = {16777216, 1048576, 2359296, 33554432, 33554432, 262144, 2048, 1048576, 1048576, 16384, 4096,
                               35717120, 12288, 24576, 16, 16, 512, 16, 16, 512, 8192, 8192, 128, 131072, 131072, 131072,
                               131072, 2048, 1048576, 2048, 2097152, 2097152, 2097152, 4194304, 1024};
      for (int ii = 0; ii < 35; ++ii) phase_csum(pin(p, ii), insz[ii], cs + 64 + pass * 64 + ii, bid, G);
    }
    phase0(p, smem, bid, G);
    gsync(grid);
    for (int layer = 0; layer < DEPTH_; ++layer) {
      unsigned long long* c = c0 + layer * 8;
      phase_gemm1(p, layer, smem, bid, G);
      gsync(grid);
      phase_csum(wsat(p, WS_PROJ), (size_t)MROWS * PP / 2, c + 0, bid, G);
      if (layer == 0) { __syncthreads(); for (int i = threadIdx.x; i < SMEM_BYTES / 4; i += 256) ((unsigned*)smem)[i] = 0u; __syncthreads(); }
      phase2(p, layer, smem, bid, G);
      __syncthreads();
      if (threadIdx.x == 0) atomicAdd(cs + 200 + pass * 4 + layer, 1ull);
      gsync(grid);
      if (threadIdx.x == 0) {
        unsigned long long seen = atomicAdd(cs + 200 + pass * 4 + layer, 0ull);
        if (seen != (unsigned long long)G) atomicAdd(cs + 199, 1ull);
      }
      phase_csum(wsat(p, WS_Y5G), (size_t)ROW_SAMPLE0 * 512 / 2, c + 1, bid, G);
      if (layer == 0) {
        gsync(grid);
      if (layer == 0) { __syncthreads(); for (int i = threadIdx.x; i < SMEM_BYTES / 4; i += 256) ((unsigned*)smem)[i] = 0u; __syncthreads(); }
        phase2(p, layer, smem, bid, G);
        gsync(grid);
        phase_csum(wsat(p, WS_Y5G), (size_t)ROW_SAMPLE0 * 512 / 2, cs + 100 + pass, bid, G);
        gsync(grid);
        phase_csum(wsat(p, WS_Y5G), (size_t)ROW_SAMPLE0 * 512 / 2, cs + 104 + pass, bid, G);
      }
      phase_csum_items(wsat(p, WS_PDN), NCHUNK * 4, DN_ITEM / 4, 73732 / 4, c + 6, bid, G);
      phase_csum_items(wsat(p, WS_PML), NCHUNK * 4, ML_ITEM / 4, 41728 / 4, c + 7, bid, G);
      phase3(p, layer, smem, bid, G);
      gsync(grid);
      phase_csum(wsat(p, WS_OBR), (size_t)MROWS * 1536 / 2, c + 2, bid, G);
      phase_gates(p, layer, smem, bid, G);
      gsync(grid);
      phase_csum(wsat(p, WS_PDN), (size_t)MROWS * 3072 / 2, c + 3, bid, G);
      phase_mix(p, layer, smem, bid, G);
      gsync(grid);
      phase_csum(wsat(p, WS_PML), (size_t)MROWS * 1024 / 2, c + 4, bid, G);
      phase_out(p, layer, smem, bid, G);
      gsync(grid);
      phase_csum(pout(p), (size_t)ROW_META0 * 1024, c + 5, bid, G);
    }
    gsync(grid);
  }
  int code = 0;
  {
    volatile unsigned long long* v = (volatile unsigned long long*)cs;
    if (v[1] != v[100]) code |= 1;
    if (v[33] != v[101]) code |= 2;
    if (v[1] != v[33]) code |= 4;
    if (v[100] != v[104]) code |= 8;
    if (v[101] != v[105]) code |= 16;
    code |= 32;
  }
  const float cval = sqrtf((float)code);
  const size_t nout = O_SS5I + (size_t)4 * 128 * 2048;
  for (size_t i = (size_t)bid * 256 + threadIdx.x; i < nout; i += (size_t)G * 256) pout(p)[i] = (i < O_YS) ? cval : 0.f;
}
#endif
#ifndef STOP_AFTER
#define STOP_AFTER 0
#endif
__global__ void dump_kernel(Params p, size_t off, size_t n_u16) {
  const size_t NY = (size_t)ROW_META0 * 1024;
  const u16* buf = (const u16*)(pws(p) + off);
  for (size_t i = (size_t)blockIdx.x * 256 + threadIdx.x; i < NY; i += (size_t)gridDim.x * 256) {
    float s = 0.f;
    for (size_t k = i; k < n_u16; k += NY) s += bf2f(buf[k]);
    pout(p)[i] = s;
  }
}

extern "C" void kernel_launch(void* const* d_in, const int* in_sizes, int n_in, void* d_out, int out_size,
                              void* d_ws, size_t ws_size, hipStream_t stream) {
  Params p{};
  for (int i = 0; i < 35; ++i) p.in[i] = (const float*)d_in[i];
  p.out = (float*)d_out;
  p.ws = (unsigned char*)d_ws;
  p.y5g_off = WS_Y5G;
  p.in[35] = (const float*)d_out;
  p.in[36] = (const float*)d_ws;
#ifdef DIAG_MEMSET
  hipMemsetAsync(d_ws, 0, WS_END, stream);
  hipMemsetAsync(d_out, 0, (size_t)out_size * 4, stream);
#endif
  if (ws_size < WS_END + (size_t)WS_PROBE_EXTRA) { fprintf(stderr, "workspace too small: %zu < %zu\n", ws_size, (size_t)WS_END); return; }
#if MULTI_LAUNCH
  const int G = 512;
  phase_kernel<0><<<G, 256, 0, stream>>>(p, 0);
#if STOP_AFTER
  {
    if (STOP_AFTER >= 1) phase_kernel<1><<<G, 256, 0, stream>>>(p, 0);
    if (STOP_AFTER >= 2) phase_kernel<2><<<G, 256, 0, stream>>>(p, 0);
    if (STOP_AFTER >= 3) phase_kernel<3><<<G, 256, 0, stream>>>(p, 0);
    if (STOP_AFTER >= 4) phase_kernel<4><<<G, 256, 0, stream>>>(p, 0);
    if (STOP_AFTER >= 5) phase_kernel<5><<<G, 256, 0, stream>>>(p, 0);
    if (STOP_AFTER >= 6) phase_kernel<6><<<G, 256, 0, stream>>>(p, 0);
    size_t off = 0, n = 0;
    if (STOP_AFTER == 1) { off = WS_PROJ; n = (size_t)MROWS * PP; }
    if (STOP_AFTER == 2) { off = WS_Y5G; n = (WS_END - WS_Y5G) / 2; }
    if (STOP_AFTER == 3) { off = WS_OBR; n = (size_t)MROWS * 1536; }
    if (STOP_AFTER == 4) { off = WS_PDN; n = (size_t)MROWS * 3072; }
    if (STOP_AFTER == 5) { off = WS_PML; n = (size_t)MROWS * 1024; }
    if (STOP_AFTER != 6) dump_kernel<<<1024, 256, 0, stream>>>(p, off, n);
    return;
  }
#endif
  for (int l = 0; l < 4; ++l) {
    phase_kernel<1><<<G, 256, 0, stream>>>(p, l);
    phase_kernel<2><<<G, 256, 0, stream>>>(p, l);
    phase_kernel<3><<<G, 256, 0, stream>>>(p, l);
    phase_kernel<4><<<G, 256, 0, stream>>>(p, l);
    phase_kernel<5><<<G, 256, 0, stream>>>(p, l);
    phase_kernel<6><<<G, 256, 0, stream>>>(p, l);
  }
  phase_kernel<7><<<G, 256, 0, stream>>>(p, 0);
#else
  static int grid_blocks = 0;
  if (!grid_blocks) {
    int dev = 0, cus = 0, per_cu = 0;
    hipGetDevice(&dev);
    hipDeviceGetAttribute(&cus, hipDeviceAttributeMultiprocessorCount, dev);
    hipOccupancyMaxActiveBlocksPerMultiprocessor(&per_cu, mega_kernel, 256, 0);
    if (per_cu > 2) per_cu = 2;
    if (per_cu < 1) per_cu = 1;
    grid_blocks = cus * per_cu;
  }
#if DIAG_SELF
  {
    static int gb2 = 0;
    if (!gb2) { int per = 0; hipOccupancyMaxActiveBlocksPerMultiprocessor(&per, diag_kernel, 256, 0); if (per > 2) per = 2; if (per < 1) per = 1; gb2 = 256 * per; }
    void* a2[] = {&p};
    hipError_t e2 = hipLaunchCooperativeKernel((void*)diag_kernel, dim3(gb2), dim3(256), a2, 0, stream);
    if (e2 != hipSuccess) fprintf(stderr, "diag launch failed\n");
    return;
  }
#endif
  void* args[] = {&p};
  hipError_t e = hipLaunchCooperativeKernel((void*)mega_kernel, dim3(grid_blocks), dim3(256), args, 0, stream);
  if (e != hipSuccess) fprintf(stderr, "cooperative launch failed: %s (grid %d)\n", hipGetErrorString(e), grid_blocks);
#endif
}
```

```cpp
#include <hip/hip_runtime.h>
#include <hip/hip_bf16.h>
#include <hip/hip_cooperative_groups.h>
#include <cstdio>
namespace cg = cooperative_groups;

typedef unsigned short u16;
using bf16x8 = __attribute__((ext_vector_type(8))) short;
using f32x4 = __attribute__((ext_vector_type(4))) float;


#define DIAG_SELF 0
#define S5_SYNTH 0
#ifndef REPEAT_MASK
#define REPEAT_MASK 0
#endif
#ifndef WS_PROBE_EXTRA
#define WS_PROBE_EXTRA 18100000
#endif
#ifndef MULTI_LAUNCH
#define MULTI_LAUNCH 0
#endif

constexpr int DEPTH_ = 4;
constexpr int MROWS = 17536;
constexpr int ROW_SAMPLE0 = 16384;
constexpr int ROW_META0 = 17408;
constexpr int MT = 137;
constexpr int PP = 5696;
constexpr int PN = 5648;
constexpr int NIN = 8720;
constexpr int NCHUNK = 392;
constexpr float NEGF = -1e30f;
constexpr float EPSF = 1e-6f;

constexpr int C_DNQ = 0, C_DNZ = 1536, C_DNA = 2048, C_DNB = 2052, C_MLQ = 2056, C_MLK = 2568, C_MLV = 3080,
              C_MLO = 3592, C_MLZ = 4104, C_MLI = 4616, C_MLF = 4620, C_S5U = 4624, C_S5Z = 5136, C_GATE = 5648;

constexpr size_t O_YP = 0;
constexpr size_t O_YS = O_YP + (size_t)8 * 2048 * 1024;
constexpr size_t O_PCONV = O_YS + (size_t)128 * 8 * 1024;
constexpr size_t O_PDNS = O_PCONV + (size_t)4 * 8 * 3 * 1536;
constexpr size_t O_PMLC = O_PDNS + (size_t)4 * 8 * 4 * 16384;
constexpr size_t O_PMLN = O_PMLC + (size_t)4 * 8 * 4 * 16384;
constexpr size_t O_PMLM = O_PMLN + (size_t)4 * 8 * 4 * 128;
constexpr size_t O_PS5R = O_PMLM + (size_t)4 * 8 * 4;
constexpr size_t O_PS5I = O_PS5R + (size_t)4 * 8 * 32 * 64;
constexpr size_t O_SCONV = O_PS5I + (size_t)4 * 8 * 32 * 64;
constexpr size_t O_SDNS = O_SCONV + (size_t)4 * 128 * 3 * 1536;
constexpr size_t O_SMLC = O_SDNS + (size_t)4 * 128 * 4 * 16384;
constexpr size_t O_SMLN = O_SMLC + (size_t)4 * 128 * 4 * 16384;
constexpr size_t O_SMLM = O_SMLN + (size_t)4 * 128 * 4 * 128;
constexpr size_t O_SS5R = O_SMLM + (size_t)4 * 128 * 4;
constexpr size_t O_SS5I = O_SS5R + (size_t)4 * 128 * 32 * 64;

constexpr size_t WS_WIN = 0;
constexpr size_t WS_WDN = WS_WIN + (size_t)4 * NIN * 1024 * 2;
constexpr size_t WS_WML = WS_WDN + (size_t)4 * 1024 * 512 * 2;
constexpr size_t WS_WS5 = WS_WML + (size_t)4 * 1024 * 512 * 2;
constexpr size_t WS_WOUT = WS_WS5 + (size_t)4 * 1024 * 512 * 2;
constexpr size_t WS_WGLU = WS_WOUT + (size_t)4 * 1024 * 1024 * 2;
constexpr size_t WS_XMETA = WS_WGLU + (size_t)4 * 512 * 512 * 2;
constexpr size_t WS_PROJ = WS_XMETA + (size_t)128 * 1024 * 4;
constexpr size_t WS_OBR = WS_PROJ + (size_t)MROWS * PP * 2;
constexpr size_t WS_Y5G = WS_OBR + (size_t)MROWS * 1536 * 2;
constexpr size_t DN_ITEM = 74240;
constexpr size_t ML_ITEM = 41984;
constexpr size_t WS_PDN = WS_Y5G + (size_t)MROWS * 512 * 2;
constexpr size_t WS_PML = WS_PDN + (size_t)NCHUNK * 4 * DN_ITEM;
constexpr size_t WS_END = WS_PML + (size_t)NCHUNK * 4 * ML_ITEM;
static_assert((size_t)MROWS * 3072 * 2 <= (size_t)NCHUNK * 4 * DN_ITEM, "gates alias");
static_assert((size_t)MROWS * 1024 * 2 <= (size_t)NCHUNK * 4 * ML_ITEM, "mixed alias");

constexpr int SMEM_BYTES = 136 * 1024;

struct Params {
  const float* in[37];
  float* out;
  unsigned char* ws;
  size_t y5g_off;
};

typedef __attribute__((ext_vector_type(2))) __bf16 bf2v;
__device__ __forceinline__ u16 f2bf(float f) {
  __bf16 h = (__bf16)f;
  return __builtin_bit_cast(u16, h);
}
__device__ __forceinline__ float bf2f(unsigned h) { return __uint_as_float((h & 0xffffu) << 16); }
__device__ __forceinline__ unsigned pack2(float a, float b) {
  bf2v r;
  r[0] = (__bf16)a; r[1] = (__bf16)b;
  return __builtin_bit_cast(unsigned, r);
}
__device__ __forceinline__ float sigmoidf_(float x) { return 1.f / (1.f + __expf(-x)); }
__device__ __forceinline__ float siluf_(float x) { return x / (1.f + __expf(-x)); }
__device__ __forceinline__ f32x4 mfma16(bf16x8 a, bf16x8 b, f32x4 c) {
  return __builtin_amdgcn_mfma_f32_16x16x32_bf16(a, b, c, 0, 0, 0);
}
__device__ __forceinline__ int opaque(int v) { asm volatile("" : "+v"(v)); return v; }
__device__ __forceinline__ bf16x8 ldg8(const u16* p) { return *reinterpret_cast<const bf16x8*>(p); }
__device__ __forceinline__ bf16x8 zero8() { bf16x8 z = {0, 0, 0, 0, 0, 0, 0, 0}; return z; }
__device__ __forceinline__ f32x4 zero4() { f32x4 z = {0.f, 0.f, 0.f, 0.f}; return z; }

__device__ __forceinline__ const float* pin(const Params& p, int i) {
  asm volatile("" : "+s"(i));
  return p.in[i];
}
__device__ __forceinline__ unsigned char* pws(const Params& p) { return (unsigned char*)pin(p, 36); }
__device__ __forceinline__ unsigned char* wsat(const Params& p, size_t off) {
  unsigned o = (unsigned)off;
  asm volatile("" : "+s"(o));
  return (unsigned char*)pin(p, 36) + o;
}
__device__ __forceinline__ float* pout(const Params& p) {
  return (float*)pin(p, 35);
}
__device__ __forceinline__ void touch_lines(const unsigned char* base, int nlines, int tid) {
  for (int i = tid; i < nlines; i += 256) {
    unsigned v = *(const unsigned*)(base + (size_t)i * 128);
    asm volatile("" :: "v"(v));
  }
}
__device__ __forceinline__ int opaque_s(int v) { asm volatile("" : "+s"(v)); return v; }
__device__ __forceinline__ float* xrow(const Params& p, int r) {
  return r < ROW_META0 ? pout(p) + (size_t)r * 1024 : (float*)(wsat(p, WS_XMETA)) + (size_t)(r - ROW_META0) * 1024;
}
__device__ __forceinline__ float* st_out(const Params& p, size_t offP, size_t offS, int layer, int q, size_t per) {
  return q < 8 ? pout(p) + offP + (size_t)(layer * 8 + q) * per : pout(p) + offS + (size_t)(layer * 128 + (q - 8)) * per;
}

struct ChunkInfo { int row0, Lv, q, hist, hrow, last; };
__device__ __forceinline__ ChunkInfo chunk_info(int ci) {
  ChunkInfo c;
  if (ci < 264) {
    int s = ci / 33, cc = ci % 33;
    c.q = s;
    c.last = (cc == 32);
    if (cc == 0) { c.row0 = ROW_META0 + s * 16; c.Lv = 16; c.hist = 0; c.hrow = 0; }
    else {
      c.row0 = s * 2048 + (cc - 1) * 64; c.Lv = 64; c.hist = 1;
      c.hrow = (cc == 1) ? (ROW_META0 + s * 16 + 13) : (c.row0 - 3);
    }
  } else {
    int s = ci - 264;
    c.q = 8 + s; c.row0 = ROW_SAMPLE0 + s * 8; c.Lv = 8; c.hist = 2; c.hrow = 0; c.last = 1;
  }
  return c;
}

__device__ __forceinline__ void transpose_tile(const float* __restrict__ src, int K, int N, u16* __restrict__ dst,
                               const float* __restrict__ scale, int kt, int nt, float* sT) {
  const int tid = opaque(threadIdx.x);
  __syncthreads();
  for (int e = tid; e < 4096; e += 256) {
    int kk = e >> 6, nn = e & 63;
    int n = nt * 64 + nn, k = kt * 64 + kk;
    float v = 0.f;
    if (n < N) { v = src[(size_t)k * N + n]; if (scale) v *= scale[k]; }
    sT[kk * 65 + nn] = v;
  }
  __syncthreads();
  for (int e = tid; e < 4096; e += 256) {
    int nn = e >> 6, kk = e & 63;
    int n = nt * 64 + nn;
    if (n < N) ((u16*)dst)[(size_t)n * K + kt * 64 + kk] = f2bf(sT[kk * 65 + nn]);
  }
}

__device__ __forceinline__ void phase0(const Params& p, unsigned char* smem, int bid, int G) {
  float* sT = (float*)smem;
  const int nIn = 4 * 16 * 137, nBr = 4 * 8 * 16, nOut = 4 * 16 * 16, nGlu = 4 * 8 * 8;
  const int total = nIn + 3 * nBr + nOut + nGlu;
  for (int it = bid; it < total; it += G) {
    int i = it;
    if (i < nIn) {
      int l = i / (16 * 137), r = i % (16 * 137);
      transpose_tile(pin(p, 11) + (size_t)l * 1024 * NIN, 1024, NIN, (u16*)(wsat(p, WS_WIN)) + (size_t)l * NIN * 1024,
                     pin(p, 10) + l * 1024, r / 137, r % 137, sT);
      continue;
    }
    i -= nIn;
    if (i < 3 * nBr) {
      int b = i / nBr, j = i % nBr;
      int l = j / 128, r = j % 128;
      const float* src = pin(p, 30 + b) + (size_t)l * 512 * 1024;
      u16* dst = (u16*)(pws(p) + (b == 0 ? WS_WDN : b == 1 ? WS_WML : WS_WS5)) + (size_t)l * 1024 * 512;
      transpose_tile(src, 512, 1024, dst, nullptr, r / 16, r % 16, sT);
      continue;
    }
    i -= 3 * nBr;
    if (i < nOut) {
      int l = i / 256, r = i % 256;
      transpose_tile(pin(p, 33) + (size_t)l * 1024 * 1024, 1024, 1024, (u16*)(wsat(p, WS_WOUT)) + (size_t)l * 1024 * 1024,
                     nullptr, r / 16, r % 16, sT);
      continue;
    }
    i -= nOut;
    {
      int l = i / 64, r = i % 64;
      transpose_tile(pin(p, 28) + (size_t)l * 512 * 512, 512, 512, (u16*)(wsat(p, WS_WGLU)) + (size_t)l * 512 * 512,
                     nullptr, r / 8, r % 8, sT);
    }
  }
  const size_t n4 = (size_t)MROWS * 256;
  for (size_t e = (size_t)bid * 256 + threadIdx.x; e < n4; e += (size_t)G * 256) {
    int r = (int)(e >> 8), c4 = (int)(e & 255);
    float4 v;
    if (r < ROW_SAMPLE0) v = ((const float4*)pin(p, 0))[(size_t)r * 256 + c4];
    else if (r < ROW_META0) v = ((const float4*)pin(p, 1))[(size_t)(r - ROW_SAMPLE0) * 256 + c4];
    else v = ((const float4*)pin(p, 9))[(size_t)((r - ROW_META0) & 15) * 256 + c4];
    ((float4*)xrow(p, r))[c4] = v;
  }
}

template <bool AF32, int TN>
__device__ __forceinline__ void gemm_kloop(f32x4 (&acc)[4][TN], const void* __restrict__ aptr,
                                           const u16* __restrict__ bptr, int K, u16* sA, u16* sB, float* ssq) {
  const int tid = opaque(threadIdx.x), lane = tid & 63, wave = tid >> 6;
  const int wm = wave >> 1, wn = wave & 1, fr = lane & 15, fq = lane >> 4;
  const int soff = (tid >> 1) * 136 + (tid & 1) * 64;
  constexpr int STG = 128 * 136;
  float sq = 0.f;
  const int nk = K / 128;
  float4 f0_0, f1_0, f2_0, f3_0, f4_0, f5_0, f6_0, f7_0, f8_0, f9_0, f10_0, f11_0, f12_0, f13_0, f14_0, f15_0, f0_1, f1_1, f2_1, f3_1, f4_1, f5_1, f6_1, f7_1, f8_1, f9_1, f10_1, f11_1, f12_1, f13_1, f14_1, f15_1;
  uint4 a0_0, a1_0, a2_0, a3_0, a4_0, a5_0, a6_0, a7_0, b0_0, b1_0, b2_0, b3_0, b4_0, b5_0, b6_0, b7_0, a0_1, a1_1, a2_1, a3_1, a4_1, a5_1, a6_1, a7_1, b0_1, b1_1, b2_1, b3_1, b4_1, b5_1, b6_1, b7_1;
#define SQ4(v) (v.x * v.x + v.y * v.y + v.z * v.z + v.w * v.w)
#define PK8(d, a, b) d.x = pack2(a.x, a.y); d.y = pack2(a.z, a.w); d.z = pack2(b.x, b.y); d.w = pack2(b.z, b.w)
#define GLOAD(S, kt) do { \
    if (AF32) { const float4* pa = (const float4*)((const float*)aptr + (kt) * 128); f0_##S = pa[0]; f1_##S = pa[1]; f2_##S = pa[2]; f3_##S = pa[3]; f4_##S = pa[4]; f5_##S = pa[5]; f6_##S = pa[6]; f7_##S = pa[7]; f8_##S = pa[8]; f9_##S = pa[9]; f10_##S = pa[10]; f11_##S = pa[11]; f12_##S = pa[12]; f13_##S = pa[13]; f14_##S = pa[14]; f15_##S = pa[15]; } \
    else { const uint4* pa = (const uint4*)((const u16*)aptr + (kt) * 128); a0_##S = pa[0]; a1_##S = pa[1]; a2_##S = pa[2]; a3_##S = pa[3]; a4_##S = pa[4]; a5_##S = pa[5]; a6_##S = pa[6]; a7_##S = pa[7]; } \
    if (TN == 4 || tid < 64 * TN) { const uint4* pb = (const uint4*)(bptr + (kt) * 128); b0_##S = pb[0]; b1_##S = pb[1]; b2_##S = pb[2]; b3_##S = pb[3]; b4_##S = pb[4]; b5_##S = pb[5]; b6_##S = pb[6]; b7_##S = pb[7]; } \
  } while (0)
#define SSTORE(S, buf) do { \
    if (AF32) { sq += SQ4(f0_##S) + SQ4(f1_##S) + SQ4(f2_##S) + SQ4(f3_##S) + SQ4(f4_##S) + SQ4(f5_##S) + SQ4(f6_##S) + SQ4(f7_##S) + SQ4(f8_##S) + SQ4(f9_##S) + SQ4(f10_##S) + SQ4(f11_##S) + SQ4(f12_##S) + SQ4(f13_##S) + SQ4(f14_##S) + SQ4(f15_##S); PK8(a0_##S, f0_##S, f1_##S); PK8(a1_##S, f2_##S, f3_##S); PK8(a2_##S, f4_##S, f5_##S); PK8(a3_##S, f6_##S, f7_##S); PK8(a4_##S, f8_##S, f9_##S); PK8(a5_##S, f10_##S, f11_##S); PK8(a6_##S, f12_##S, f13_##S); PK8(a7_##S, f14_##S, f15_##S); } \
    uint4* da = (uint4*)(sA + (buf) * STG + soff); da[0] = a0_##S; da[1] = a1_##S; da[2] = a2_##S; da[3] = a3_##S; da[4] = a4_##S; da[5] = a5_##S; da[6] = a6_##S; da[7] = a7_##S; \
    if (TN == 4 || tid < 64 * TN) { uint4* db = (uint4*)(sB + (buf) * STG + soff); db[0] = b0_##S; db[1] = b1_##S; db[2] = b2_##S; db[3] = b3_##S; db[4] = b4_##S; db[5] = b5_##S; db[6] = b6_##S; db[7] = b7_##S; } \
  } while (0)
  auto compute = [&](int buf) {
#pragma unroll
    for (int kk = 0; kk < 4; ++kk) {
      bf16x8 af[4], bfr[TN];
#pragma unroll
      for (int i = 0; i < 4; ++i) af[i] = *(const bf16x8*)(sA + buf * STG + (wm * 64 + i * 16 + fr) * 136 + kk * 32 + fq * 8);
#pragma unroll
      for (int j = 0; j < TN; ++j) bfr[j] = *(const bf16x8*)(sB + buf * STG + (wn * TN * 16 + j * 16 + fr) * 136 + kk * 32 + fq * 8);
#pragma unroll
      for (int i = 0; i < 4; ++i)
#pragma unroll
        for (int j = 0; j < TN; ++j) acc[i][j] = mfma16(af[i], bfr[j], acc[i][j]);
    }
  };
  __syncthreads();
  GLOAD(0, 0);
  GLOAD(1, 1);
  SSTORE(0, 0);
  __syncthreads();
  for (int kt = 0; kt < nk; kt += 2) {
    if (kt + 2 < nk) GLOAD(0, kt + 2);
    compute(0);
    SSTORE(1, 1);
    __syncthreads();
    if (kt + 3 < nk) GLOAD(1, kt + 3);
    compute(1);
    if (kt + 2 < nk) SSTORE(0, 0);
    __syncthreads();
  }
  if (AF32) *ssq = sq;
}

__device__ __forceinline__ u16* xnrow_fwd(const Params& p, int r) {
  return r < 8704 ? (u16*)wsat(p, WS_Y5G) + (size_t)r * 1024
                  : (u16*)wsat(p, WS_END + 8192) + (size_t)(r - 8704) * 1024;
}
struct GemmSmem {
  u16 A[2 * 128 * 136];
  u16 B[2 * 128 * 136];
};

template <int MODE>
__device__ __forceinline__ void gemm_in_tile(const Params& p, int layer_, int mt, int nt, unsigned char* smem) {
  const int layer = opaque_s(layer_);
  GemmSmem* s = (GemmSmem*)smem;
  const int tid = opaque(threadIdx.x), lane = tid & 63, wave = tid >> 6;
  const int wm = wave >> 1, wn = wave & 1, fr = lane & 15, fq = lane >> 4;
  const int m0 = mt * 128, n0 = nt * 128;
  const int N = MODE == 0 ? PN : 3072;
  const int wrow0 = MODE == 0 ? 0 : C_GATE;
  const u16* aptr = xnrow_fwd(p, m0 + (tid >> 1)) + (tid & 1) * 64;
  int bn = n0 + (tid >> 1); if (bn > N - 1) bn = N - 1;
  const u16* bptr = (const u16*)(wsat(p, WS_WIN)) + ((size_t)layer * NIN + wrow0 + bn) * 1024 + (tid & 1) * 64;
  f32x4 acc[4][4];
#pragma unroll
  for (int i = 0; i < 4; ++i)
#pragma unroll
    for (int j = 0; j < 4; ++j) acc[i][j] = zero4();
  gemm_kloop<false, 4>(acc, aptr, bptr, 1024, s->A, s->B, nullptr);
  u16* dst = MODE == 0 ? (u16*)(wsat(p, WS_PROJ)) : (u16*)(wsat(p, WS_PDN));
  const int pitch = MODE == 0 ? PP : 3072;
#pragma unroll
  for (int i = 0; i < 4; ++i)
#pragma unroll
    for (int r = 0; r < 4; ++r) {
      const int rl = wm * 64 + i * 16 + fq * 4 + r;
#pragma unroll
      for (int j = 0; j < 4; ++j) {
        const int col = n0 + wn * 64 + j * 16 + fr;
        if (col < N) {
          float v = acc[i][j][r];
          if (MODE == 1) v = sigmoidf_(v + pin(p, 12)[layer * 3072 + col]);
          dst[(size_t)(m0 + rl) * pitch + col] = f2bf(v);
        }
      }
    }
}

__device__ __forceinline__ void gemm_glu_tile(const Params& p, int layer_, int mt, int nt, unsigned char* smem) {
  const int layer = opaque_s(layer_);
  GemmSmem* s = (GemmSmem*)smem;
  const int tid = opaque(threadIdx.x), lane = tid & 63, wave = tid >> 6;
  const int wm = wave >> 1, wn = wave & 1, fr = lane & 15, fq = lane >> 4;
  const int m0 = mt * 128, n0 = nt * 128;
  const u16* y5g = (const u16*)(wsat(p, WS_Y5G));
  const u16* proj = (const u16*)(wsat(p, WS_PROJ));
  const u16* aptr = y5g + (size_t)(m0 + (tid >> 1)) * 512 + (tid & 1) * 64;
  const u16* bptr = (const u16*)(wsat(p, WS_WGLU)) + ((size_t)layer * 512 + n0 + (tid >> 1)) * 512 + (tid & 1) * 64;
  f32x4 acc[4][4];
#pragma unroll
  for (int i = 0; i < 4; ++i)
#pragma unroll
    for (int j = 0; j < 4; ++j) acc[i][j] = zero4();
  gemm_kloop<false, 4>(acc, aptr, bptr, 512, s->A, s->B, nullptr);
  u16* obr = (u16*)(wsat(p, WS_OBR));
#pragma unroll
  for (int i = 0; i < 4; ++i)
#pragma unroll
    for (int r = 0; r < 4; ++r) {
      const int row = m0 + wm * 64 + i * 16 + fq * 4 + r;
#pragma unroll
      for (int j = 0; j < 4; ++j) {
        const int col = n0 + wn * 64 + j * 16 + fr;
        float y = bf2f(y5g[(size_t)row * 512 + col]);
        float z = bf2f(proj[(size_t)row * PP + C_S5Z + col]);
        float v = y * sigmoidf_(acc[i][j][r] + pin(p, 29)[layer * 512 + col]) * siluf_(z);
        obr[(size_t)row * 1536 + 1024 + col] = f2bf(v);
      }
    }
}

__device__ __forceinline__ void gemm_mix_tile(const Params& p, int layer_, int mt, int nt, unsigned char* smem) {
  const int layer = opaque_s(layer_);
  GemmSmem* s = (GemmSmem*)smem;
  const int tid = opaque(threadIdx.x), lane = tid & 63, wave = tid >> 6;
  const int wm = wave >> 1, wn = wave & 1, fr = lane & 15, fq = lane >> 4;
  const int m0 = mt * 128, n0 = nt * 64;
  const u16* obr = (const u16*)(wsat(p, WS_OBR));
  const u16* gates = (const u16*)(wsat(p, WS_PDN));
  f32x4 res[4][2];
#pragma unroll
  for (int i = 0; i < 4; ++i)
#pragma unroll
    for (int j = 0; j < 2; ++j) res[i][j] = zero4();
#pragma unroll 1
  for (int b = 0; b < 3; ++b) {
    const u16* aptr = obr + (size_t)(m0 + (tid >> 1)) * 1536 + b * 512 + (tid & 1) * 64;
    const u16* wb = (const u16*)(pws(p) + (b == 0 ? WS_WDN : b == 1 ? WS_WML : WS_WS5));
    const u16* bptr = wb + ((size_t)layer * 1024 + n0 + ((tid >> 1) & 63)) * 512 + (tid & 1) * 64;
    f32x4 acc[4][2];
#pragma unroll
    for (int i = 0; i < 4; ++i)
#pragma unroll
      for (int j = 0; j < 2; ++j) acc[i][j] = zero4();
    gemm_kloop<false, 2>(acc, aptr, bptr, 512, s->A, s->B, nullptr);
#pragma unroll
    for (int i = 0; i < 4; ++i)
#pragma unroll
      for (int r = 0; r < 4; ++r) {
        const int row = m0 + wm * 64 + i * 16 + fq * 4 + r;
#pragma unroll
        for (int j = 0; j < 2; ++j) {
          const int col = n0 + wn * 32 + j * 16 + fr;
          float g = bf2f(gates[(size_t)row * 3072 + b * 1024 + col]);
          res[i][j][r] += g * acc[i][j][r];
        }
      }
  }
  u16* mixed = (u16*)(wsat(p, WS_PML));
#pragma unroll
  for (int i = 0; i < 4; ++i)
#pragma unroll
    for (int r = 0; r < 4; ++r) {
      const int row = m0 + wm * 64 + i * 16 + fq * 4 + r;
#pragma unroll
      for (int j = 0; j < 2; ++j) {
        const int col = n0 + wn * 32 + j * 16 + fr;
        mixed[(size_t)row * 1024 + col] = f2bf(res[i][j][r]);
      }
    }
}

__device__ __forceinline__ void gemm_out_tile(const Params& p, int layer_, int mt, int nt, unsigned char* smem) {
  const int layer = opaque_s(layer_);
  GemmSmem* s = (GemmSmem*)smem;
  const int tid = opaque(threadIdx.x), lane = tid & 63, wave = tid >> 6;
  const int wm = wave >> 1, wn = wave & 1, fr = lane & 15, fq = lane >> 4;
  const int m0 = mt * 128, n0 = nt * 128;
  const u16* mixed = (const u16*)(wsat(p, WS_PML));
  const u16* aptr = mixed + (size_t)(m0 + (tid >> 1)) * 1024 + (tid & 1) * 64;
  const u16* bptr = (const u16*)(wsat(p, WS_WOUT)) + ((size_t)layer * 1024 + n0 + (tid >> 1)) * 1024 + (tid & 1) * 64;
  f32x4 acc[4][4];
#pragma unroll
  for (int i = 0; i < 4; ++i)
#pragma unroll
    for (int j = 0; j < 4; ++j) acc[i][j] = zero4();
  gemm_kloop<false, 4>(acc, aptr, bptr, 1024, s->A, s->B, nullptr);
#pragma unroll
  for (int i = 0; i < 4; ++i)
#pragma unroll
    for (int r = 0; r < 4; ++r) {
      const int row = m0 + wm * 64 + i * 16 + fq * 4 + r;
      float* xr = xrow(p, row);
#pragma unroll
      for (int j = 0; j < 4; ++j) {
        const int col = n0 + wn * 64 + j * 16 + fr;
        xr[col] += acc[i][j][r];
      }
    }
}

__device__ __forceinline__ void prep_dn(const Params& p, int layer_, int ci, int h, unsigned char* smem) {
  const int layer = opaque_s(layer_);
  const int tid = opaque(threadIdx.x), lane = tid & 63, wave = tid >> 6, fr = lane & 15, fq = lane >> 4;
  const ChunkInfo c = chunk_info(ci);
  float* sAm = (float*)smem;
  float* sG = (float*)(smem + 17408);
  u16* qb = (u16*)(smem + 18432);
  u16* kb = qb + 64 * 136;
  u16* vb = kb + 64 * 136;
  float* sBeta = sG + 64;
  float* sEG = sBeta + 64;
  const u16* proj = (const u16*)(wsat(p, WS_PROJ));
  unsigned char* item = wsat(p, WS_PDN) + (size_t)(ci * 4 + h) * DN_ITEM;
  u16* gU = (u16*)item;
  u16* gW = gU + opaque_s(8192);
  u16* gQe = gW + opaque_s(8192);
  u16* gKdT = gQe + opaque_s(8192);
  u16* gAttn = gKdT + opaque_s(8192);
  float* gScal = (float*)(item + opaque_s(73728));

  __syncthreads();
  if (wave == 0) {
    float g = 0.f, beta = 0.f;
    if (lane < c.Lv) {
      const u16* pr = proj + (size_t)(c.row0 + lane) * PP;
      float a = bf2f(pr[C_DNA + h]), bb = bf2f(pr[C_DNB + h]);
      float x = a + pin(p, 15)[layer * 4 + h];
      float sp = x > 20.f ? x : log1pf(__expf(x));
      g = -__expf(pin(p, 14)[layer * 4 + h]) * sp;
      beta = sigmoidf_(bb);
    }
    float G = g;
#pragma unroll
    for (int d = 1; d < 64; d <<= 1) { float t = __shfl_up(G, d); if (lane >= d) G += t; }
    sG[lane] = G; sBeta[lane] = beta; sEG[lane] = __expf(G);
  }
  const float* convw = pin(p, 13) + (size_t)layer * 4 * 1536;
#pragma unroll 1
  for (int part = 0; part < 3; ++part) {
    const int cb = part * 512 + h * 128 + 2 * lane;
    float w0[4], w1[4];
#pragma unroll
    for (int j = 0; j < 4; ++j) { w0[j] = convw[j * 1536 + cb]; w1[j] = convw[j * 1536 + cb + 1]; }
    u16* dst = part == 0 ? qb : (part == 1 ? kb : vb);
#pragma unroll 8
    for (int rr = 0; rr < 16; ++rr) {
      const int l = wave * 16 + rr;
      float o0 = 0.f, o1 = 0.f;
      if (l < c.Lv) {
#pragma unroll
        for (int j = 0; j < 4; ++j) {
          const int i = l + j - 3;
          float x0 = 0.f, x1 = 0.f;
          if (i >= 0) {
            unsigned v = *(const unsigned*)(proj + (size_t)(c.row0 + i) * PP + cb);
            x0 = bf2f(v); x1 = bf2f(v >> 16);
          } else if (c.hist == 1) {
            unsigned v = *(const unsigned*)(proj + (size_t)(c.hrow + i + 3) * PP + cb);
            x0 = bf2f(v); x1 = bf2f(v >> 16);
          } else if (c.hist == 2) {
            const float* st = pin(p, 2) + ((size_t)(layer * 128 + (c.q - 8)) * 3 + (i + 3)) * 1536 + cb;
            x0 = st[0]; x1 = st[1];
          }
          o0 += w0[j] * x0; o1 += w1[j] * x1;
        }
        o0 = siluf_(o0); o1 = siluf_(o1);
      }
      if (part < 2) {
        float ss = o0 * o0 + o1 * o1;
#pragma unroll
        for (int d = 32; d >= 1; d >>= 1) ss += __shfl_xor(ss, d);
        float sc = rsqrtf(ss + EPSF);
        if (part == 0) sc *= 0.08838834764831845f;
        o0 *= sc; o1 *= sc;
      }
      *(unsigned*)(dst + l * 136 + 2 * lane) = pack2(o0, o1);
    }
  }
  __syncthreads();
  {
    f32x4 akk[4], aqk[4];
#pragma unroll
    for (int j = 0; j < 4; ++j) { akk[j] = zero4(); aqk[j] = zero4(); }
#pragma unroll
    for (int ks = 0; ks < 4; ++ks) {
      bf16x8 aq = *(const bf16x8*)(qb + (wave * 16 + fr) * 136 + ks * 32 + fq * 8);
      bf16x8 ak = *(const bf16x8*)(kb + (wave * 16 + fr) * 136 + ks * 32 + fq * 8);
#pragma unroll
      for (int j = 0; j < 4; ++j) {
        bf16x8 b = *(const bf16x8*)(kb + (j * 16 + fr) * 136 + ks * 32 + fq * 8);
        akk[j] = mfma16(ak, b, akk[j]);
        aqk[j] = mfma16(aq, b, aqk[j]);
      }
    }
#pragma unroll
    for (int j = 0; j < 4; ++j)
#pragma unroll
      for (int r = 0; r < 4; ++r) {
        const int row = wave * 16 + fq * 4 + r, col = j * 16 + fr;
        float dec = (col <= row) ? __expf(sG[row] - sG[col]) : 0.f;
        sAm[row * 68 + col] = (col < row) ? sBeta[row] * akk[j][r] * dec : 0.f;
        gAttn[row * 64 + col] = f2bf(aqk[j][r] * dec);
      }
  }
  __syncthreads();
#ifndef SKIP_SOLVE
  {
    float x[64];
    const u16* rsrc = tid < 128 ? vb + tid : kb + (tid - 128);
    const bool isw = tid >= 128;
#pragma unroll
    for (int l = 0; l < 64; ++l) {
      float sacc = bf2f(rsrc[l * 136]) * sBeta[l];
      if (isw) sacc *= sEG[l];
#pragma unroll
      for (int j0 = 0; j0 < l; j0 += 16) {
#pragma unroll
        for (int j = j0; j < (j0 + 16 < l ? j0 + 16 : l); ++j) sacc -= sAm[l * 68 + j] * x[j];
        asm volatile("" ::: "memory");
      }
      x[l] = sacc;
    }
    u16* dstc = tid < 128 ? gU + tid : gW + (tid - 128);
#pragma unroll
    for (int l = 0; l < 64; ++l) dstc[l * 128] = f2bf(x[l]);
  }
#endif
  const float Glast = sG[63];
  for (int e = tid; e < 8192; e += 256) {
    int l = e >> 7, k = e & 127;
    gQe[e] = f2bf(bf2f(qb[l * 136 + k]) * sEG[l]);
  }
  for (int e = tid; e < 8192; e += 256) {
    int k = e >> 6, l = e & 63;
    gKdT[e] = f2bf(bf2f(kb[l * 136 + k]) * __expf(Glast - sG[l]));
  }
  if (tid == 0) gScal[0] = __expf(Glast);
  if (c.last) {
    float* oc = st_out(p, O_PCONV, O_SCONV, layer, c.q, 3 * 1536);
    for (int e = tid; e < 1152; e += 256) {
      int j = e / 384, rem = e % 384, part = rem >> 7, ch = rem & 127;
      int col = part * 512 + h * 128 + ch;
      oc[j * 1536 + col] = bf2f(proj[(size_t)(c.row0 + c.Lv - 3 + j) * PP + col]);
    }
  }
}

__device__ __forceinline__ void prep_ml(const Params& p, int layer_, int ci, int h, unsigned char* smem) {
  const int layer = opaque_s(layer_);
  const int tid = opaque(threadIdx.x), lane = tid & 63, wave = tid >> 6, fr = lane & 15, fq = lane >> 4;
  const ChunkInfo c = chunk_info(ci);
  u16* qb = (u16*)smem;
  u16* kb = qb + 64 * 136;
  u16* vb = kb + 64 * 136;
  const u16* proj = (const u16*)(wsat(p, WS_PROJ));
  unsigned char* item = wsat(p, WS_PML) + (size_t)(ci * 4 + h) * ML_ITEM;
  u16* gQK = (u16*)item;
  u16* gKT = gQK + opaque_s(4096);
  u16* gVT = gKT + opaque_s(8192);
  float* gVec = (float*)(item + opaque_s(40960));

  __syncthreads();
  if (wave == 0) {
    float ig = NEGF, lf = 0.f;
    if (lane < c.Lv) {
      const u16* pr = proj + (size_t)(c.row0 + lane) * PP;
      ig = bf2f(pr[C_MLI + h]) + pin(p, 17)[layer * 4 + h];
      float x = bf2f(pr[C_MLF + h]) + pin(p, 18)[layer * 4 + h];
      lf = (x < -20.f) ? x : -log1pf(__expf(-x));
    }
    float b = lf;
#pragma unroll
    for (int d = 1; d < 64; d <<= 1) { float t = __shfl_up(b, d); if (lane >= d) b += t; }
    float pm = ig - b;
#pragma unroll
    for (int d = 1; d < 64; d <<= 1) { float t = __shfl_up(pm, d); if (lane >= d) pm = fmaxf(pm, t); }
    gVec[lane] = b; gVec[64 + lane] = ig; gVec[128 + lane] = b + pm;
  }
  for (int e = tid; e < 64 * 16 * 3; e += 256) {
    int part = e / 1024, rem = e % 1024, l = rem >> 4, seg = rem & 15;
    uint4 v = make_uint4(0, 0, 0, 0);
    if (l < c.Lv) v = *(const uint4*)(proj + (size_t)(c.row0 + l) * PP + C_MLQ + part * 512 + h * 128 + seg * 8);
    if (part == 1) {
      const float sc = 0.08838834764831845f;
      v.x = pack2(bf2f(v.x) * sc, bf2f(v.x >> 16) * sc);
      v.y = pack2(bf2f(v.y) * sc, bf2f(v.y >> 16) * sc);
      v.z = pack2(bf2f(v.z) * sc, bf2f(v.z >> 16) * sc);
      v.w = pack2(bf2f(v.w) * sc, bf2f(v.w >> 16) * sc);
    }
    u16* dst = part == 0 ? qb : (part == 1 ? kb : vb);
    *(uint4*)(dst + l * 136 + seg * 8) = v;
  }
  __syncthreads();
  {
    f32x4 aqk[4];
#pragma unroll
    for (int j = 0; j < 4; ++j) aqk[j] = zero4();
#pragma unroll
    for (int ks = 0; ks < 4; ++ks) {
      bf16x8 aq = *(const bf16x8*)(qb + (wave * 16 + fr) * 136 + ks * 32 + fq * 8);
#pragma unroll
      for (int j = 0; j < 4; ++j) {
        bf16x8 b = *(const bf16x8*)(kb + (j * 16 + fr) * 136 + ks * 32 + fq * 8);
        aqk[j] = mfma16(aq, b, aqk[j]);
      }
    }
#pragma unroll
    for (int j = 0; j < 4; ++j)
#pragma unroll
      for (int r = 0; r < 4; ++r) {
        const int row = wave * 16 + fq * 4 + r, col = j * 16 + fr;
        gQK[row * 64 + col] = f2bf(aqk[j][r]);
      }
  }
  for (int e = tid; e < 8192; e += 256) {
    int k = e >> 6, l = e & 63;
    gKT[e] = kb[l * 136 + k];
    gVT[e] = vb[l * 136 + k];
  }
}

__device__ __forceinline__ void seq_dn(const Params& p, int layer_, int q, int h, unsigned char* smem) {
  const int layer = opaque_s(layer_);
  const int tid = opaque(threadIdx.x), lane = tid & 63, wave = tid >> 6, fr = lane & 15, fq = lane >> 4;
  u16* sST = (u16*)smem + wave * (32 * 136);
  u16* sVT = (u16*)(smem + 34816) + wave * (32 * 72);
  float* sSS = (float*)(smem + 53248);
  const u16* proj = (const u16*)(wsat(p, WS_PROJ));
  u16* obr = (u16*)(wsat(p, WS_OBR));
  const float* normw = pin(p, 16) + layer * 128;
  f32x4 st[2][8];
  int nch, ci0;
  if (q < 8) { nch = 33; ci0 = q * 33; } else { nch = 1; ci0 = 264 + (q - 8); }
  if (q < 8) {
#pragma unroll
    for (int i = 0; i < 2; ++i)
#pragma unroll
      for (int j = 0; j < 8; ++j) st[i][j] = zero4();
  } else {
    const float* s0 = pin(p, 3) + ((size_t)(layer * 128 + (q - 8)) * 4 + h) * 16384;
#pragma unroll
    for (int i = 0; i < 2; ++i)
#pragma unroll
      for (int j = 0; j < 8; ++j) {
        float4 v = *(const float4*)(s0 + (j * 16 + fr) * 128 + wave * 32 + i * 16 + fq * 4);
        st[i][j][0] = v.x; st[i][j][1] = v.y; st[i][j][2] = v.z; st[i][j][3] = v.w;
      }
  }
#pragma unroll 1
  for (int cc = 0; cc < nch; ++cc) {
    const int ci = ci0 + cc;
    const ChunkInfo c = chunk_info(ci);
    const unsigned char* item = wsat(p, WS_PDN) + (size_t)(ci * 4 + h) * DN_ITEM;
    const u16* gU = (const u16*)item;
    const u16* gW = gU + opaque_s(8192);
    const u16* gQe = gW + opaque_s(8192);
    const u16* gKdT = gQe + opaque_s(8192);
    const u16* gAttn = gKdT + opaque_s(8192);
    const float eg = *(const float*)(item + opaque_s(73728));
    if (cc + 1 < nch) {
      const unsigned char* nb = item + DN_ITEM * 4 + (size_t)tid * 128;
      unsigned v0 = *(const unsigned*)nb, v1 = *(const unsigned*)(nb + 32768), v2 = *(const unsigned*)(nb + 65536 - 256 * 0);
      unsigned v3 = *(const unsigned*)((const unsigned char*)(proj + (size_t)(q * 2048 + cc * 64 + (tid >> 2)) * PP + C_DNZ + h * 128) + (tid & 1) * 128);
      asm volatile("" :: "v"(v0), "v"(v1), "v"(v2), "v"(v3));
    }
    __syncthreads();
#pragma unroll
    for (int i = 0; i < 2; ++i)
#pragma unroll
      for (int j = 0; j < 8; ++j)
#pragma unroll
        for (int r = 0; r < 4; ++r) sST[(i * 16 + fq * 4 + r) * 136 + j * 16 + fr] = f2bf(st[i][j][r]);
    __syncthreads();
#pragma unroll 1
    for (int hf = 0; hf < 2; ++hf) {
      f32x4 vn[2][2];
#pragma unroll
      for (int i = 0; i < 2; ++i) { vn[i][0] = zero4(); vn[i][1] = zero4(); }
#pragma unroll
      for (int ks = 0; ks < 4; ++ks) {
        bf16x8 b0 = *(const bf16x8*)(sST + (fr) * 136 + ks * 32 + fq * 8);
        bf16x8 b1 = *(const bf16x8*)(sST + (16 + fr) * 136 + ks * 32 + fq * 8);
#pragma unroll
        for (int i = 0; i < 2; ++i) {
          bf16x8 a = ldg8(gW + ((hf * 2 + i) * 16 + fr) * 128 + ks * 32 + fq * 8);
          vn[i][0] = mfma16(a, b0, vn[i][0]);
          vn[i][1] = mfma16(a, b1, vn[i][1]);
        }
      }
#pragma unroll
      for (int i = 0; i < 2; ++i)
#pragma unroll
        for (int jn = 0; jn < 2; ++jn) {
          const int nl = jn * 16 + fr;
          float v[4];
#pragma unroll
          for (int r = 0; r < 4; ++r) {
            const int l = (hf * 2 + i) * 16 + fq * 4 + r;
            v[r] = bf2f(gU[l * 128 + wave * 32 + nl]) - vn[i][jn][r];
          }
          uint2 pk; pk.x = pack2(v[0], v[1]); pk.y = pack2(v[2], v[3]);
          *(uint2*)(sVT + nl * 72 + (hf * 2 + i) * 16 + fq * 4) = pk;
        }
    }
    __syncthreads();
#pragma unroll 1
    for (int hf = 0; hf < 2; ++hf) {
      f32x4 o[2][2];
#pragma unroll
      for (int i = 0; i < 2; ++i) { o[i][0] = zero4(); o[i][1] = zero4(); }
#pragma unroll
      for (int ks = 0; ks < 4; ++ks) {
        bf16x8 b0 = *(const bf16x8*)(sST + (fr) * 136 + ks * 32 + fq * 8);
        bf16x8 b1 = *(const bf16x8*)(sST + (16 + fr) * 136 + ks * 32 + fq * 8);
#pragma unroll
        for (int i = 0; i < 2; ++i) {
          bf16x8 a = ldg8(gQe + ((hf * 2 + i) * 16 + fr) * 128 + ks * 32 + fq * 8);
          o[i][0] = mfma16(a, b0, o[i][0]);
          o[i][1] = mfma16(a, b1, o[i][1]);
        }
      }
#pragma unroll
      for (int ks = 0; ks < 2; ++ks) {
        bf16x8 b0 = *(const bf16x8*)(sVT + (fr) * 72 + ks * 32 + fq * 8);
        bf16x8 b1 = *(const bf16x8*)(sVT + (16 + fr) * 72 + ks * 32 + fq * 8);
#pragma unroll
        for (int i = 0; i < 2; ++i) {
          bf16x8 a = ldg8(gAttn + ((hf * 2 + i) * 16 + fr) * 64 + ks * 32 + fq * 8);
          o[i][0] = mfma16(a, b0, o[i][0]);
          o[i][1] = mfma16(a, b1, o[i][1]);
        }
      }
#pragma unroll
      for (int i = 0; i < 2; ++i)
#pragma unroll
        for (int r = 0; r < 4; ++r) {
          float ss = o[i][0][r] * o[i][0][r] + o[i][1][r] * o[i][1][r];
          ss += __shfl_xor(ss, 1); ss += __shfl_xor(ss, 2); ss += __shfl_xor(ss, 4); ss += __shfl_xor(ss, 8);
          if (fr == 0) sSS[wave * 64 + (hf * 2 + i) * 16 + fq * 4 + r] = ss;
        }
      __syncthreads();
#pragma unroll
      for (int i = 0; i < 2; ++i)
#pragma unroll
        for (int r = 0; r < 4; ++r) {
          const int l = (hf * 2 + i) * 16 + fq * 4 + r;
          if (l < c.Lv) {
            float tot = sSS[l] + sSS[64 + l] + sSS[128 + l] + sSS[192 + l];
            float rstd = rsqrtf(tot * (1.f / 128.f) + EPSF);
#pragma unroll
            for (int jn = 0; jn < 2; ++jn) {
              const int n = wave * 32 + jn * 16 + fr;
              float z = bf2f(proj[(size_t)(c.row0 + l) * PP + C_DNZ + h * 128 + n]);
              float val = o[i][jn][r] * rstd * normw[n] * siluf_(z);
              obr[(size_t)(c.row0 + l) * 1536 + h * 128 + n] = f2bf(val);
            }
          }
        }
    }
#pragma unroll
    for (int i = 0; i < 2; ++i)
#pragma unroll
      for (int j = 0; j < 8; ++j) st[i][j] *= eg;
#pragma unroll
    for (int ks = 0; ks < 2; ++ks) {
      bf16x8 a0 = *(const bf16x8*)(sVT + (fr) * 72 + ks * 32 + fq * 8);
      bf16x8 a1 = *(const bf16x8*)(sVT + (16 + fr) * 72 + ks * 32 + fq * 8);
#pragma unroll
      for (int j = 0; j < 8; ++j) {
        bf16x8 b = ldg8(gKdT + (j * 16 + fr) * 64 + ks * 32 + fq * 8);
        st[0][j] = mfma16(a0, b, st[0][j]);
        st[1][j] = mfma16(a1, b, st[1][j]);
      }
    }
  }
  float* so = st_out(p, O_PDNS, O_SDNS, layer, q, 65536) + (size_t)h * 16384;
#pragma unroll
  for (int i = 0; i < 2; ++i)
#pragma unroll
    for (int j = 0; j < 8; ++j) {
      float4 v; v.x = st[i][j][0]; v.y = st[i][j][1]; v.z = st[i][j][2]; v.w = st[i][j][3];
      *(float4*)(so + (j * 16 + fr) * 128 + wave * 32 + i * 16 + fq * 4) = v;
    }
}

__device__ __forceinline__ void seq_ml(const Params& p, int layer_, int q, int h, unsigned char* smem) {
  const int layer = opaque_s(layer_);
  const int tid = opaque(threadIdx.x), lane = tid & 63, wave = tid >> 6, fr = lane & 15, fq = lane >> 4;
  u16* sCT = (u16*)smem + wave * (32 * 136);
  float* sSS = (float*)(smem + 34816);
  float* sN = sSS + 256;
  float* sB = sN + 128;
  float* sIg = sB + 64;
  float* sMt = sIg + 64;
  float* sWi = sMt + 64;
  float* sWs = sWi + 64;
  float* sQn = sWs + 64;
  float* sDen = sQn + 64;
  const u16* proj = (const u16*)(wsat(p, WS_PROJ));
  u16* obr = (u16*)(wsat(p, WS_OBR));
  const float* normw = pin(p, 19) + layer * 128;
  f32x4 st[2][8];
  int nch, ci0;
  float m;
  if (q < 8) { nch = 33; ci0 = q * 33; } else { nch = 1; ci0 = 264 + (q - 8); }
  __syncthreads();
  if (q < 8) {
#pragma unroll
    for (int i = 0; i < 2; ++i)
#pragma unroll
      for (int j = 0; j < 8; ++j) st[i][j] = zero4();
    if (tid < 128) sN[tid] = 0.f;
    m = NEGF;
  } else {
    const float* s0 = pin(p, 4) + ((size_t)(layer * 128 + (q - 8)) * 4 + h) * 16384;
#pragma unroll
    for (int i = 0; i < 2; ++i)
#pragma unroll
      for (int j = 0; j < 8; ++j) {
        float4 v = *(const float4*)(s0 + (j * 16 + fr) * 128 + wave * 32 + i * 16 + fq * 4);
        st[i][j][0] = v.x; st[i][j][1] = v.y; st[i][j][2] = v.z; st[i][j][3] = v.w;
      }
    if (tid < 128) sN[tid] = pin(p, 5)[((size_t)(layer * 128 + (q - 8)) * 4 + h) * 128 + tid];
    m = pin(p, 6)[(size_t)(layer * 128 + (q - 8)) * 4 + h];
  }
#pragma unroll 1
  for (int cc = 0; cc < nch; ++cc) {
    const int ci = ci0 + cc;
    const ChunkInfo c = chunk_info(ci);
    const unsigned char* item = wsat(p, WS_PML) + (size_t)(ci * 4 + h) * ML_ITEM;
    const u16* gQK = (const u16*)item;
    const u16* gKT = gQK + opaque_s(4096);
    const u16* gVT = gKT + opaque_s(8192);
    const float* gVec = (const float*)(item + opaque_s(40960));
    const float blast = gVec[63];
    const float m_new = fmaxf(blast + m, gVec[128 + 63]);
    const float carry = __expf(blast + m - m_new);
    if (cc + 1 < nch) {
      const unsigned char* nb = item + ML_ITEM * 4 + (size_t)tid * 128;
      unsigned v0 = *(const unsigned*)nb, v1 = *(const unsigned*)(nb + 32768 - 23552);
      const int rrow = tid >> 2, part = tid & 3;
      const int col = (part == 0) ? C_MLQ : (part == 1) ? C_MLO : C_MLZ;
      const unsigned char* b = (const unsigned char*)(proj + (size_t)(q * 2048 + cc * 64 + rrow) * PP + col + h * 128);
      unsigned v2 = *(const unsigned*)b, v3 = *(const unsigned*)(b + 128);
      asm volatile("" :: "v"(v0), "v"(v1), "v"(v2), "v"(v3));
    }
    __syncthreads();
#pragma unroll
    for (int i = 0; i < 2; ++i)
#pragma unroll
      for (int j = 0; j < 8; ++j)
#pragma unroll
        for (int r = 0; r < 4; ++r) sCT[(i * 16 + fq * 4 + r) * 136 + j * 16 + fr] = f2bf(st[i][j][r]);
    if (tid < 64) {
      float b = gVec[tid], ig = gVec[64 + tid], lm = gVec[128 + tid];
      float mt = fmaxf(b + m, lm);
      sB[tid] = b; sIg[tid] = ig; sMt[tid] = mt;
      sWi[tid] = __expf(b + m - mt);
      sWs[tid] = __expf(blast - b + ig - m_new);
    }
    {
      const int l = tid >> 2, part = tid & 3;
      float acc = 0.f;
      if (l < c.Lv) {
        const u16* qp = proj + (size_t)(c.row0 + l) * PP + C_MLQ + h * 128 + part * 32;
#pragma unroll
        for (int s4 = 0; s4 < 4; ++s4) {
          uint4 v = *(const uint4*)(qp + s4 * 8);
          const float* nn = sN + part * 32 + s4 * 8;
          acc += bf2f(v.x) * nn[0] + bf2f(v.x >> 16) * nn[1] + bf2f(v.y) * nn[2] + bf2f(v.y >> 16) * nn[3] +
                 bf2f(v.z) * nn[4] + bf2f(v.z >> 16) * nn[5] + bf2f(v.w) * nn[6] + bf2f(v.w >> 16) * nn[7];
        }
      }
      acc += __shfl_xor(acc, 1); acc += __shfl_xor(acc, 2);
      if (part == 0) sQn[l] = acc;
    }
    __syncthreads();
#pragma unroll 1
    for (int hf = 0; hf < 2; ++hf) {
      f32x4 o[2][2];
#pragma unroll
      for (int i = 0; i < 2; ++i) { o[i][0] = zero4(); o[i][1] = zero4(); }
#pragma unroll
      for (int ks = 0; ks < 4; ++ks) {
        bf16x8 b0 = *(const bf16x8*)(sCT + (fr) * 136 + ks * 32 + fq * 8);
        bf16x8 b1 = *(const bf16x8*)(sCT + (16 + fr) * 136 + ks * 32 + fq * 8);
#pragma unroll
        for (int i = 0; i < 2; ++i) {
          const int l = (hf * 2 + i) * 16 + fr;
          bf16x8 a = zero8();
          if (l < c.Lv) a = ldg8(proj + (size_t)(c.row0 + l) * PP + C_MLQ + h * 128 + ks * 32 + fq * 8);
          o[i][0] = mfma16(a, b0, o[i][0]);
          o[i][1] = mfma16(a, b1, o[i][1]);
        }
      }
#pragma unroll
      for (int i = 0; i < 2; ++i)
#pragma unroll
        for (int r = 0; r < 4; ++r) {
          const float wi = sWi[(hf * 2 + i) * 16 + fq * 4 + r];
          o[i][0][r] *= wi; o[i][1][r] *= wi;
        }
      float rs[2] = {0.f, 0.f};
#pragma unroll
      for (int ks = 0; ks < 2; ++ks) {
        bf16x8 b0 = ldg8(gVT + (wave * 32 + fr) * 64 + ks * 32 + fq * 8);
        bf16x8 b1 = ldg8(gVT + (wave * 32 + 16 + fr) * 64 + ks * 32 + fq * 8);
#pragma unroll
        for (int i = 0; i < 2; ++i) {
          const int fr_o = opaque(fr), fq_o = opaque(fq);
          const int l = (hf * 2 + i) * 16 + fr_o;
          bf16x8 qk = ldg8(gQK + l * 64 + ks * 32 + fq_o * 8);
          const float bl = sB[l], mtl = sMt[l];
          bf16x8 a;
#pragma unroll
          for (int e = 0; e < 8; ++e) {
            const int jj = ks * 32 + fq_o * 8 + e;
            float w = (jj <= l) ? __expf(bl - sB[jj] + sIg[jj] - mtl) : 0.f;
            float sv = bf2f((unsigned)(u16)qk[e]) * w;
            rs[i] += sv;
            a[e] = (short)f2bf(sv);
          }
          o[i][0] = mfma16(a, b0, o[i][0]);
          o[i][1] = mfma16(a, b1, o[i][1]);
        }
      }
#pragma unroll
      for (int i = 0; i < 2; ++i) {
        float v = rs[i];
        v += __shfl_xor(v, 16); v += __shfl_xor(v, 32);
        const int l = (hf * 2 + i) * 16 + fr;
        if (fq == 0) sDen[wave * 64 + l] = sWi[l] * sQn[l] + v;
      }
      __syncthreads();
#pragma unroll
      for (int i = 0; i < 2; ++i)
#pragma unroll
        for (int r = 0; r < 4; ++r) {
          const int l = (hf * 2 + i) * 16 + fq * 4 + r;
          float den = fmaxf(fabsf(sDen[wave * 64 + l]), __expf(-sMt[l]));
          float inv = 1.f / den;
          o[i][0][r] *= inv; o[i][1][r] *= inv;
          float ss = o[i][0][r] * o[i][0][r] + o[i][1][r] * o[i][1][r];
          ss += __shfl_xor(ss, 1); ss += __shfl_xor(ss, 2); ss += __shfl_xor(ss, 4); ss += __shfl_xor(ss, 8);
          if (fr == 0) sSS[wave * 64 + l] = ss;
        }
      __syncthreads();
#pragma unroll
      for (int i = 0; i < 2; ++i)
#pragma unroll
        for (int r = 0; r < 4; ++r) {
          const int l = (hf * 2 + i) * 16 + fq * 4 + r;
          if (l < c.Lv) {
            float tot = sSS[l] + sSS[64 + l] + sSS[128 + l] + sSS[192 + l];
            float rstd = rsqrtf(tot * (1.f / 128.f) + EPSF);
#pragma unroll
            for (int jn = 0; jn < 2; ++jn) {
              const int n = wave * 32 + jn * 16 + fr;
              const u16* pr = proj + (size_t)(c.row0 + l) * PP;
              float og = bf2f(pr[C_MLO + h * 128 + n]);
              float z = bf2f(pr[C_MLZ + h * 128 + n]);
              float val = o[i][jn][r] * rstd * normw[n] * sigmoidf_(og) * siluf_(z);
              obr[(size_t)(c.row0 + l) * 1536 + 512 + h * 128 + n] = f2bf(val);
            }
          }
        }
    }
    __syncthreads();
    if (tid < 128) {
      float acc = carry * sN[tid];
      const u16* kr = gKT + tid * 64;
#pragma unroll
      for (int s8 = 0; s8 < 8; ++s8) {
        uint4 v = *(const uint4*)(kr + s8 * 8);
        const float* ww = sWs + s8 * 8;
        acc += bf2f(v.x) * ww[0] + bf2f(v.x >> 16) * ww[1] + bf2f(v.y) * ww[2] + bf2f(v.y >> 16) * ww[3] +
               bf2f(v.z) * ww[4] + bf2f(v.z >> 16) * ww[5] + bf2f(v.w) * ww[6] + bf2f(v.w >> 16) * ww[7];
      }
      sN[tid] = acc;
    }
#pragma unroll
    for (int i = 0; i < 2; ++i)
#pragma unroll
      for (int j = 0; j < 8; ++j) st[i][j] *= carry;
#pragma unroll
    for (int ks = 0; ks < 2; ++ks) {
      bf16x8 a[2];
#pragma unroll
      for (int i = 0; i < 2; ++i) {
        bf16x8 raw = ldg8(gVT + (wave * 32 + i * 16 + fr) * 64 + ks * 32 + fq * 8);
#pragma unroll
        for (int e = 0; e < 8; ++e)
          a[i][e] = (short)f2bf(bf2f((unsigned)(u16)raw[e]) * sWs[ks * 32 + fq * 8 + e]);
      }
#pragma unroll
      for (int j = 0; j < 8; ++j) {
        bf16x8 b = ldg8(gKT + (j * 16 + fr) * 64 + ks * 32 + fq * 8);
        st[0][j] = mfma16(a[0], b, st[0][j]);
        st[1][j] = mfma16(a[1], b, st[1][j]);
      }
    }
    m = m_new;
  }
  __syncthreads();
  float* so = st_out(p, O_PMLC, O_SMLC, layer, q, 65536) + (size_t)h * 16384;
#pragma unroll
  for (int i = 0; i < 2; ++i)
#pragma unroll
    for (int j = 0; j < 8; ++j) {
      float4 v; v.x = st[i][j][0]; v.y = st[i][j][1]; v.z = st[i][j][2]; v.w = st[i][j][3];
      *(float4*)(so + (j * 16 + fr) * 128 + wave * 32 + i * 16 + fq * 4) = v;
    }
  if (tid < 128) st_out(p, O_PMLN, O_SMLN, layer, q, 512)[h * 128 + tid] = sN[tid];
  if (tid == 0) st_out(p, O_PMLM, O_SMLM, layer, q, 4)[h] = m;
}

__device__ __forceinline__ void s5_chain(const Params& p, int layer_, int q, int gq, unsigned char* smem) {
  const int layer = opaque_s(layer_);
  const int tid = opaque(threadIdx.x), lane = tid & 63, wave = tid >> 6, fr = lane & 15, fq = lane >> 4;
  const int g = gq * 4 + wave;
  float* sBu = (float*)smem + wave * (16 * 132);
  float* sHf = (float*)(smem + 33792) + wave * (16 * 132);
  const u16* proj = (const u16*)(wsat(p, WS_PROJ));
  u16* y5g = (u16*)(wsat(p, WS_Y5G));
  const float* lre = pin(p, 20) + (size_t)(layer * 32 + g) * 64;
  const float* lim = pin(p, 21) + (size_t)(layer * 32 + g) * 64;
  const float dt = __expf(pin(p, 22)[layer * 32 + g]);
  float lbr, lbi;
  {
    float zr = lre[lane] * dt, zi = lim[lane] * dt;
    float e = __expf(zr);
    lbr = e * __cosf(zi); lbi = e * __sinf(zi);
  }
  bf16x8 bB[8];
#pragma unroll
  for (int j = 0; j < 8; ++j) {
    const int pp = j * 16 + fr, ps = pp & 63, isim = pp >> 6;
    float ar = lre[ps], ai = lim[ps];
    float zr = ar * dt, zi = ai * dt;
    float e = __expf(zr);
    float br_ = e * __cosf(zi) - 1.f, bi_ = e * __sinf(zi);
    float den = ar * ar + ai * ai;
    float cr = (br_ * ar + bi_ * ai) / den;
    float cim = (bi_ * ar - br_ * ai) / den;
    bB[j] = zero8();
    if (fq < 2) {
      const float* bre = pin(p, 23) + ((size_t)(layer * 32 + g) * 64 + ps) * 16 + fq * 8;
      const float* bim = pin(p, 24) + ((size_t)(layer * 32 + g) * 64 + ps) * 16 + fq * 8;
#pragma unroll
      for (int e2 = 0; e2 < 8; ++e2) {
        float v = isim ? (cr * bim[e2] + cim * bre[e2]) : (cr * bre[e2] - cim * bim[e2]);
        bB[j][e2] = (short)f2bf(v);
      }
    }
  }
  bf16x8 bC[4];
#pragma unroll
  for (int ks = 0; ks < 4; ++ks) {
#pragma unroll
    for (int e2 = 0; e2 < 8; ++e2) {
      const int pp = ks * 32 + fq * 8 + e2;
      float v = (pp < 64) ? pin(p, 25)[((size_t)(layer * 32 + g) * 16 + fr) * 64 + pp]
                          : -pin(p, 26)[((size_t)(layer * 32 + g) * 16 + fr) * 64 + (pp - 64)];
      bC[ks][e2] = (short)f2bf(v);
    }
  }
  const float dcoef = pin(p, 27)[layer * 512 + g * 16 + fr];
  float hr = 0.f, hi = 0.f;
  int nst;
  if (q < 8) nst = 129;
  else {
    nst = 1;
    hr = pin(p, 7)[((size_t)(layer * 128 + (q - 8)) * 32 + g) * 64 + lane];
    hi = pin(p, 8)[((size_t)(layer * 128 + (q - 8)) * 32 + g) * 64 + lane];
  }
  auto s5_rows = [&](int stp_, int& row0_, int& nv_) {
    if (q < 8) { nv_ = 16; row0_ = (stp_ == 0) ? (ROW_META0 + q * 16) : (q * 2048 + (stp_ - 1) * 16); }
    else { nv_ = 8; row0_ = ROW_SAMPLE0 + (q - 8) * 8; }
  };
  auto s5_load = [&](int row0_, int nv_) {
    bf16x8 a_ = zero8();
    if (fq < 2 && fr < nv_) a_ = ldg8(proj + (size_t)(row0_ + fr) * PP + C_S5U + g * 16 + fq * 8);
    return a_;
  };
  bf16x8 au_next;
  { int r0, n0_; s5_rows(0, r0, n0_); au_next = s5_load(r0, n0_); }
#pragma unroll 1
  for (int stp = 0; stp < nst; ++stp) {
    int row0, nv;
    s5_rows(stp, row0, nv);
    bf16x8 au = au_next;
    if (stp + 1 < nst) { int r1, n1; s5_rows(stp + 1, r1, n1); au_next = s5_load(r1, n1); }
    __syncthreads();
#pragma unroll
    for (int j = 0; j < 8; ++j) {
      f32x4 acc = zero4();
      acc = mfma16(au, bB[j], acc);
      asm volatile("s_nop 15\n\ts_nop 15" : "+v"(acc));
#pragma unroll
      for (int r = 0; r < 4; ++r) sBu[(fq * 4 + r) * 132 + j * 16 + fr] = acc[r];
    }
    __syncthreads();
    for (int t = 0; t < nv; ++t) {
      float br = sBu[t * 132 + lane], bi = sBu[t * 132 + 64 + lane];
      float nr = lbr * hr - lbi * hi + br;
      float ni = lbr * hi + lbi * hr + bi;
      hr = nr; hi = ni;
      sHf[t * 132 + lane] = hr;
      sHf[t * 132 + 64 + lane] = hi;
    }
    for (int t = nv; t < 16; ++t) { sHf[t * 132 + lane] = 0.f; sHf[t * 132 + 64 + lane] = 0.f; }
    __syncthreads();
    f32x4 y = zero4();
#pragma unroll
    for (int ks = 0; ks < 4; ++ks) {
      const float4 h0 = *(const float4*)(sHf + fr * 132 + ks * 32 + fq * 8);
      const float4 h1 = *(const float4*)(sHf + fr * 132 + ks * 32 + fq * 8 + 4);
      bf16x8 a;
      a[0] = (short)f2bf(h0.x); a[1] = (short)f2bf(h0.y); a[2] = (short)f2bf(h0.z); a[3] = (short)f2bf(h0.w);
      a[4] = (short)f2bf(h1.x); a[5] = (short)f2bf(h1.y); a[6] = (short)f2bf(h1.z); a[7] = (short)f2bf(h1.w);
      y = mfma16(a, bC[ks], y);
    }
    asm volatile("s_nop 15\n\ts_nop 15" : "+v"(y));
#pragma unroll
    for (int r = 0; r < 4; ++r) {
      const int t = fq * 4 + r;
      if (t < nv) {
#if S5_SYNTH
        float u = bf2f(f2bf((float)((((row0 + t) * 31 + (g * 16 + fr) * 7) & 255)) * (1.f / 256.f) - 0.5f));
#else
        float u = bf2f(proj[(size_t)(row0 + t) * PP + C_S5U + g * 16 + fr]);
#endif
        const float dco = pin(p, 27)[layer * 512 + g * 16 + fr];
        float v = y[r] + dco * u;
        float inner = 0.7978845608028654f * (v + 0.044715f * v * v * v);
        float th = 1.f - 2.f / (1.f + __expf(2.f * inner));
        float ge = 0.5f * v * (1.f + th);
#if S5_SYNTH == 2
        ge = (float)((((row0 + t) * 13 + (g * 16 + fr) * 5) & 127)) * 0.01f;
#endif
#if S5_SYNTH == 5
        ge = sBu[t * 132 + fr * 8] + sBu[t * 132 + fr * 8 + 5];
#endif
#if S5_SYNTH == 6
        ge = bf2f((unsigned)(u16)bB[fr & 7][r]) + lbr + bf2f((unsigned)(u16)bC[r][fr & 7]);
#endif
#if S5_SYNTH == 4
        ge = sHf[t * 132 + fr * 8] + sHf[t * 132 + fr * 8 + 3];
#endif
#if S5_SYNTH == 3
        ge = y[r];
#endif
        y5g[(size_t)(row0 + t) * 512 + g * 16 + fr] = f2bf(ge);
      }
    }
  }
  st_out(p, O_PS5R, O_SS5R, layer, q, 2048)[g * 64 + lane] = hr;
  st_out(p, O_PS5I, O_SS5I, layer, q, 2048)[g * 64 + lane] = hi;
}


__device__ __forceinline__ void phase_xnorm(const Params& p, int bid_, int G_) {
  const int bid = opaque_s(bid_), G = opaque_s(G_);
  const int tidf = opaque(threadIdx.x);
  const int lane = tidf & 63, wave = tidf >> 6;
  for (int r = bid * 4 + wave; r < MROWS; r += G * 4) {
    const float4* xr = (const float4*)xrow(p, r);
    float4 v[4];
    float ss = 0.f;
#pragma unroll
    for (int i = 0; i < 4; ++i) {
      v[i] = xr[i * 64 + lane];
      ss += v[i].x * v[i].x + v[i].y * v[i].y + v[i].z * v[i].z + v[i].w * v[i].w;
    }
#pragma unroll
    for (int d = 32; d >= 1; d >>= 1) ss += __shfl_xor(ss, d);
    const float rstd = rsqrtf(ss * (1.f / 1024.f) + EPSF);
    uint2* dst = (uint2*)xnrow_fwd(p, r);
#pragma unroll
    for (int i = 0; i < 4; ++i) {
      uint2 o;
      o.x = pack2(v[i].x * rstd, v[i].y * rstd);
      o.y = pack2(v[i].z * rstd, v[i].w * rstd);
      dst[i * 64 + lane] = o;
    }
  }
}
__device__ __forceinline__ void phase_gemm1(const Params& p, int layer_, unsigned char* smem, int bid_, int G_) {
  const int layer = opaque_s(layer_), bid = opaque_s(bid_), G = opaque_s(G_);
  for (int t = bid; t < MT * 45; t += G) gemm_in_tile<0>(p, layer, t / 45, t % 45, smem);
}
__device__ __forceinline__ void phase2(const Params& p, int layer_, unsigned char* smem, int bid_, int G_) {
  const int layer = opaque_s(layer_), bid = opaque_s(bid_), G = opaque_s(G_);
  const int nshort = 1568 + 1568 + 1024;
  for (int it0 = bid; it0 < 64 + nshort; it0 += (bid < 64 ? (1 << 28) : G - 64)) {
    const int it = it0 - 64;
    int kind, a, b;
    if (it0 < 64) { kind = 2; a = it0 >> 3; b = it0 & 7; }
    else if (it < 1568) { kind = 0; a = it >> 2; b = it & 3; }
    else if (it < 3136) { kind = 1; a = (it - 1568) >> 2; b = (it - 1568) & 3; }
    else { kind = 2; a = 8 + ((it - 3136) >> 3); b = (it - 3136) & 7; }
#ifndef SKIP_A
    if (kind == 0) prep_dn(p, layer, a, b, smem);
#endif
#ifndef SKIP_B
    if (kind == 1) prep_ml(p, layer, a, b, smem);
#endif
#ifndef SKIP_C
    if (kind == 2) s5_chain(p, layer, a, b, smem);
#endif
  }
}
__device__ __forceinline__ void phase3(const Params& p, int layer_, unsigned char* smem, int bid_, int G_) {
  const int layer = opaque_s(layer_), bid = opaque_s(bid_), G = opaque_s(G_);
  const int nshort = 512 + 512 + MT * 4;
  for (int it0 = bid; it0 < 64 + nshort; it0 += (bid < 64 ? (1 << 28) : G - 64)) {
    const int it = it0 - 64;
    int kind, a, b;
    if (it0 < 32) { kind = 0; a = it0 >> 2; b = it0 & 3; }
    else if (it0 < 64) { kind = 1; a = (it0 - 32) >> 2; b = it0 & 3; }
    else if (it < 512) { kind = 0; a = 8 + (it >> 2); b = it & 3; }
    else if (it < 1024) { kind = 1; a = 8 + ((it - 512) >> 2); b = it & 3; }
    else { kind = 2; a = (it - 1024) >> 2; b = (it - 1024) & 3; }
#ifndef SKIP_A
    if (kind == 0) seq_dn(p, layer, a, b, smem);
#endif
#ifndef SKIP_B
    if (kind == 1) seq_ml(p, layer, a, b, smem);
#endif
#ifndef SKIP_C
    if (kind == 2) gemm_glu_tile(p, layer, a, b, smem);
#endif
  }
}
__device__ __forceinline__ void phase_gates(const Params& p, int layer_, unsigned char* smem, int bid_, int G_) {
  const int layer = opaque_s(layer_), bid = opaque_s(bid_), G = opaque_s(G_);
  for (int t = bid; t < MT * 24; t += G) gemm_in_tile<1>(p, layer, t / 24, t % 24, smem);
}
__device__ __forceinline__ void phase_mix(const Params& p, int layer_, unsigned char* smem, int bid_, int G_) {
  const int layer = opaque_s(layer_), bid = opaque_s(bid_), G = opaque_s(G_);
  for (int t = bid; t < MT * 16; t += G) gemm_mix_tile(p, layer, t >> 4, t & 15, smem);
}
__device__ __forceinline__ void phase_out(const Params& p, int layer_, unsigned char* smem, int bid_, int G_) {
  const int layer = opaque_s(layer_), bid = opaque_s(bid_), G = opaque_s(G_);
  for (int t = bid; t < MT * 8; t += G) gemm_out_tile(p, layer, t >> 3, t & 7, smem);
}
__device__ __forceinline__ void phase_final(const Params& p, int bid, int G) {
  const int tidf = opaque(threadIdx.x); const int lane = tidf & 63, wave = tidf >> 6;
  for (int r = bid * 4 + wave; r < ROW_META0; r += G * 4) {
    float4* xr = (float4*)(pout(p) + (size_t)r * 1024);
    float4 v[4];
    float ss = 0.f;
#pragma unroll
    for (int i = 0; i < 4; ++i) {
      v[i] = xr[i * 64 + lane];
      ss += v[i].x * v[i].x + v[i].y * v[i].y + v[i].z * v[i].z + v[i].w * v[i].w;
    }
#pragma unroll
    for (int d = 32; d >= 1; d >>= 1) ss += __shfl_xor(ss, d);
    float rstd = rsqrtf(ss * (1.f / 1024.f) + EPSF);
#pragma unroll
    for (int i = 0; i < 4; ++i) {
      float4 w = ((const float4*)pin(p, 34))[i * 64 + lane];
      v[i].x *= rstd * w.x; v[i].y *= rstd * w.y; v[i].z *= rstd * w.z; v[i].w *= rstd * w.w;
      xr[i * 64 + lane] = v[i];
    }
  }
}

#ifndef SYS_FENCE
#define SYS_FENCE 0
#endif

__device__ __forceinline__ void gsync(cg::grid_group& grid) {
#if SYS_FENCE
  asm volatile("s_waitcnt vmcnt(0) lgkmcnt(0)" ::: "memory");
  __syncthreads();
  if (threadIdx.x == 0) {
    __builtin_amdgcn_fence(__ATOMIC_RELEASE, "");
    asm volatile("s_waitcnt vmcnt(0)" ::: "memory");
  }
  __syncthreads();
#endif
  grid.sync();
#if SYS_FENCE
  if (threadIdx.x == 0) {
    __builtin_amdgcn_fence(__ATOMIC_ACQUIRE, "");
    asm volatile("s_waitcnt vmcnt(0)" ::: "memory");
  }
  __syncthreads();
#endif
}
__global__ void __launch_bounds__(256) mega_kernel(Params p) {
  __shared__ __attribute__((aligned(16))) unsigned char smem[SMEM_BYTES];
  cg::grid_group grid = cg::this_grid();
  const int bid = blockIdx.x, G = gridDim.x;
  phase0(p, smem, bid, G);
  gsync(grid);
  for (int layer = 0; layer < DEPTH_; ++layer) {
#pragma unroll 1
    for (int st = 0; st < 8; ++st) {
      if (st == 0 || st == 4) phase_xnorm(p, bid, G);
      else if (st == 1) phase_gemm1(p, layer, smem, bid, G);
      else if (st == 2) phase2(p, layer, smem, bid, G);
      else if (st == 3) phase3(p, layer, smem, bid, G);
      else if (st == 5) phase_gates(p, layer, smem, bid, G);
      else if (st == 6) phase_mix(p, layer, smem, bid, G);
      else phase_out(p, layer, smem, bid, G);
      gsync(grid);
    }
  }
  phase_final(p, bid, G);
}

#if MULTI_LAUNCH
template <int PH>
__global__ void __launch_bounds__(256) phase_kernel(Params p, int layer) {
  __shared__ __attribute__((aligned(16))) unsigned char smem[SMEM_BYTES];
  const int bid = blockIdx.x, G = gridDim.x;
  if (PH == 0) phase0(p, smem, bid, G);
  if (PH == 1) phase_gemm1(p, layer, smem, bid, G);
  if (PH == 2) phase2(p, layer, smem, bid, G);
  if (PH == 3) phase3(p, layer, smem, bid, G);
  if (PH == 4) phase_gates(p, layer, smem, bid, G);
  if (PH == 5) phase_mix(p, layer, smem, bid, G);
  if (PH == 6) phase_out(p, layer, smem, bid, G);
  if (PH == 7) phase_final(p, bid, G);
}
#endif


#ifndef DIAG_SELF
#define DIAG_SELF 0
#endif
#if DIAG_SELF
__device__ __forceinline__ void phase_csum(const void* buf, size_t nwords, unsigned long long* dst, int bid, int G) {
  const unsigned* w = (const unsigned*)buf;
  unsigned long long s = 0;
  for (size_t i = (size_t)bid * 256 + threadIdx.x; i < nwords; i += (size_t)G * 256)
    s += (unsigned long long)w[i] * (unsigned long long)((i & 0xffff) + 1);
  atomicAdd(dst, s);
}
__device__ __forceinline__ void phase_csum_items(const void* buf, int nitems, size_t item_words, size_t valid_words, unsigned long long* dst, int bid, int G) {
  const unsigned* w = (const unsigned*)buf;
  unsigned long long s = 0;
  const size_t total = (size_t)nitems * valid_words;
  for (size_t i = (size_t)bid * 256 + threadIdx.x; i < total; i += (size_t)G * 256) {
    size_t it = i / valid_words, o = i % valid_words;
    s += (unsigned long long)w[it * item_words + o] * (unsigned long long)((i & 0xffff) + 1);
  }
  atomicAdd(dst, s);
}
__global__ void __launch_bounds__(256) diag_kernel(Params p) {
  unsigned long long* cs = (unsigned long long*)(wsat(p, WS_END));
  __shared__ __attribute__((aligned(16))) unsigned char smem[SMEM_BYTES];
  cg::grid_group grid = cg::this_grid();
  const int bid = blockIdx.x, G = gridDim.x;
  if (bid == 0) cs[threadIdx.x] = 0ull;
  for (int pass = 0; pass < 2; ++pass) {
    unsigned long long* c0 = cs + pass * 32;
    {
      const size_t insz[35] = {16777216, 1048576, 2359296, 33554432, 33554432, 262144, 2048, 1048576, 1048576, 16384, 4096,
                               35717120, 12288, 24576, 16, 16, 512, 16, 16, 512, 8192, 8192, 128, 131072, 131072, 131072,
                               131072, 2048, 1048576, 2048, 2097152, 2097152, 2097152, 4194304, 1024};
      for (int ii = 0; ii < 35; ++ii) phase_csum(pin(p, ii), insz[ii], cs + 64 + pass * 64 + ii, bid, G);
    }
    phase0(p, smem, bid, G);
    gsync(grid);
    for (int layer = 0; layer < DEPTH_; ++layer) {
      unsigned long long* c = c0 + layer * 8;
      phase_gemm1(p, layer, smem, bid, G);
      gsync(grid);
      phase_csum(wsat(p, WS_PROJ), (size_t)MROWS * PP / 2, c + 0, bid, G);
      if (layer == 0) { __syncthreads(); for (int i = threadIdx.x; i < SMEM_BYTES / 4; i += 256) ((unsigned*)smem)[i] = 0u; __syncthreads(); }
      phase2(p, layer, smem, bid, G);
      __syncthreads();
      if (threadIdx.x == 0) atomicAdd(cs + 200 + pass * 4 + layer, 1ull);
      gsync(grid);
      if (threadIdx.x == 0) {
        unsigned long long seen = atomicAdd(cs + 200 + pass * 4 + layer, 0ull);
        if (seen != (unsigned long long)G) atomicAdd(cs + 199, 1ull);
      }
      phase_csum(wsat(p, WS_Y5G), (size_t)ROW_SAMPLE0 * 512 / 2, c + 1, bid, G);
      if (layer == 0) {
        gsync(grid);
      if (layer == 0) { __syncthreads(); for (int i = threadIdx.x; i < SMEM_BYTES / 4; i += 256) ((unsigned*)smem)[i] = 0u; __syncthreads(); }
        phase2(p, layer, smem, bid, G);
        gsync(grid);
        phase_csum(wsat(p, WS_Y5G), (size_t)ROW_SAMPLE0 * 512 / 2, cs + 100 + pass, bid, G);
        gsync(grid);
        phase_csum(wsat(p, WS_Y5G), (size_t)ROW_SAMPLE0 * 512 / 2, cs + 104 + pass, bid, G);
      }
      phase_csum_items(wsat(p, WS_PDN), NCHUNK * 4, DN_ITEM / 4, 73732 / 4, c + 6, bid, G);
      phase_csum_items(wsat(p, WS_PML), NCHUNK * 4, ML_ITEM / 4, 41728 / 4, c + 7, bid, G);
      phase3(p, layer, smem, bid, G);
      gsync(grid);
      phase_csum(wsat(p, WS_OBR), (size_t)MROWS * 1536 / 2, c + 2, bid, G);
      phase_gates(p, layer, smem, bid, G);
      gsync(grid);
      phase_csum(wsat(p, WS_PDN), (size_t)MROWS * 3072 / 2, c + 3, bid, G);
      phase_mix(p, layer, smem, bid, G);
      gsync(grid);
      phase_csum(wsat(p, WS_PML), (size_t)MROWS * 1024 / 2, c + 4, bid, G);
      phase_out(p, layer, smem, bid, G);
      gsync(grid);
      phase_csum(pout(p), (size_t)ROW_META0 * 1024, c + 5, bid, G);
    }
    gsync(grid);
  }
  int code = 0;
  {
    volatile unsigned long long* v = (volatile unsigned long long*)cs;
    if (v[1] != v[100]) code |= 1;
    if (v[33] != v[101]) code |= 2;
    if (v[1] != v[33]) code |= 4;
    if (v[100] != v[104]) code |= 8;
    if (v[101] != v[105]) code |= 16;
    code |= 32;
  }
  const float cval = sqrtf((float)code);
  const size_t nout = O_SS5I + (size_t)4 * 128 * 2048;
  for (size_t i = (size_t)bid * 256 + threadIdx.x; i < nout; i += (size_t)G * 256) pout(p)[i] = (i < O_YS) ? cval : 0.f;
}
#endif
#ifndef STOP_AFTER
#define STOP_AFTER 0
#endif
__global__ void dump_kernel(Params p, size_t off, size_t n_u16) {
  const size_t NY = (size_t)ROW_META0 * 1024;
  const u16* buf = (const u16*)(pws(p) + off);
  for (size_t i = (size_t)blockIdx.x * 256 + threadIdx.x; i < NY; i += (size_t)gridDim.x * 256) {
    float s = 0.f;
    for (size_t k = i; k < n_u16; k += NY) s += bf2f(buf[k]);
    pout(p)[i] = s;
  }
}

extern "C" void kernel_launch(void* const* d_in, const int* in_sizes, int n_in, void* d_out, int out_size,
                              void* d_ws, size_t ws_size, hipStream_t stream) {
  Params p{};
  for (int i = 0; i < 35; ++i) p.in[i] = (const float*)d_in[i];
  p.out = (float*)d_out;
  p.ws = (unsigned char*)d_ws;
  p.y5g_off = WS_Y5G;
  p.in[35] = (const float*)d_out;
  p.in[36] = (const float*)d_ws;
#ifdef DIAG_MEMSET
  hipMemsetAsync(d_ws, 0, WS_END, stream);
  hipMemsetAsync(d_out, 0, (size_t)out_size * 4, stream);
#endif
  if (ws_size < WS_END + (size_t)WS_PROBE_EXTRA) { fprintf(stderr, "workspace too small: %zu < %zu\n", ws_size, (size_t)WS_END); return; }
#if MULTI_LAUNCH
  const int G = 512;
  phase_kernel<0><<<G, 256, 0, stream>>>(p, 0);
#if STOP_AFTER
  {
    if (STOP_AFTER >= 1) phase_kernel<1><<<G, 256, 0, stream>>>(p, 0);
    if (STOP_AFTER >= 2) phase_kernel<2><<<G, 256, 0, stream>>>(p, 0);
    if (STOP_AFTER >= 3) phase_kernel<3><<<G, 256, 0, stream>>>(p, 0);
    if (STOP_AFTER >= 4) phase_kernel<4><<<G, 256, 0, stream>>>(p, 0);
    if (STOP_AFTER >= 5) phase_kernel<5><<<G, 256, 0, stream>>>(p, 0);
    if (STOP_AFTER >= 6) phase_kernel<6><<<G, 256, 0, stream>>>(p, 0);
    size_t off = 0, n = 0;
    if (STOP_AFTER == 1) { off = WS_PROJ; n = (size_t)MROWS * PP; }
    if (STOP_AFTER == 2) { off = WS_Y5G; n = (WS_END - WS_Y5G) / 2; }
    if (STOP_AFTER == 3) { off = WS_OBR; n = (size_t)MROWS * 1536; }
    if (STOP_AFTER == 4) { off = WS_PDN; n = (size_t)MROWS * 3072; }
    if (STOP_AFTER == 5) { off = WS_PML; n = (size_t)MROWS * 1024; }
    if (STOP_AFTER != 6) dump_kernel<<<1024, 256, 0, stream>>>(p, off, n);
    return;
  }
#endif
  for (int l = 0; l < 4; ++l) {
    phase_kernel<1><<<G, 256, 0, stream>>>(p, l);
    phase_kernel<2><<<G, 256, 0, stream>>>(p, l);
    phase_kernel<3><<<G, 256, 0, stream>>>(p, l);
    phase_kernel<4><<<G, 256, 0, stream>>>(p, l);
    phase_kernel<5><<<G, 256, 0, stream>>>(p, l);
    phase_kernel<6><<<G, 256, 0, stream>>>(p, l);
  }
  phase_kernel<7><<<G, 256, 0, stream>>>(p, 0);
#else
  static int grid_blocks = 0;
  if (!grid_blocks) {
    int dev = 0, cus = 0, per_cu = 0;
    hipGetDevice(&dev);
    hipDeviceGetAttribute(&cus, hipDeviceAttributeMultiprocessorCount, dev);
    hipOccupancyMaxActiveBlocksPerMultiprocessor(&per_cu, mega_kernel, 256, 0);
    if (per_cu > 2) per_cu = 2;
    if (per_cu < 1) per_cu = 1;
    grid_blocks = cus * per_cu;
  }
#if DIAG_SELF
  {
    static int gb2 = 0;
    if (!gb2) { int per = 0; hipOccupancyMaxActiveBlocksPerMultiprocessor(&per, diag_kernel, 256, 0); if (per > 2) per = 2; if (per < 1) per = 1; gb2 = 256 * per; }
    void* a2[] = {&p};
    hipError_t e2 = hipLaunchCooperativeKernel((void*)diag_kernel, dim3(gb2), dim3(256), a2, 0, stream);
    if (e2 != hipSuccess) fprintf(stderr, "diag launch failed\n");
    return;
  }
#endif
  void* args[] = {&p};
  hipError_t e = hipLaunchCooperativeKernel((void*)mega_kernel, dim3(grid_blocks), dim3(256), args, 0, stream);
  if (e != hipSuccess) fprintf(stderr, "cooperative launch failed: %s (grid %d)\n", hipGetErrorString(e), grid_blocks);
#endif
}
```
